# Optimizing an MI355X kernel written in HIP

```python
import math
import jax, jax.numpy as jnp
from jax import lax
import numpy as np

D_MODEL = 4096
BATCH = 4
SEQ = 4096
DEPTH = 1

CHUNK = 64
N_META = 16
HEAD_DIM = 128
H_FOX = D_MODEL // (2 * HEAD_DIM)
H_DSA = D_MODEL // (2 * HEAD_DIM)
W_FOX = H_FOX * HEAD_DIM
W_DSA = H_DSA * HEAD_DIM
H_IDX = 32
D_IDX = 64
TOPK_MAX = 256
D_FF = 4 * D_MODEL
N_BUCKETS = 32
MAX_DISTANCE = 128
FOX_BLOCK = 128
DSA_BLOCK = 32
N_BRANCH = 2
RMS_EPS = 1e-6
IN_SPLITS = (W_FOX, W_FOX, W_FOX, H_FOX, W_DSA, W_DSA, W_DSA, H_IDX * D_IDX, D_IDX, H_IDX, N_BRANCH * D_MODEL)
D_IN = 3 * W_FOX + H_FOX + 3 * W_DSA + H_IDX * D_IDX + D_IDX + H_IDX + N_BRANCH * D_MODEL

kernel_name = "gated_fox_dsa_hybrid_block"


def rmsnorm(x, g):
    xf = x.astype(jnp.float32)
    y = xf * lax.rsqrt(jnp.mean(xf * xf, axis=-1, keepdims=True) + RMS_EPS)
    return (y * g.astype(jnp.float32)).astype(x.dtype)


def chunk_ids(n):
    p = jnp.arange(n)
    return jnp.where(p < N_META, 0, (p - N_META) // CHUNK + 1)


def t5_bucket(rel):
    half = N_BUCKETS // 2
    max_exact = half // 2
    ret = jnp.where(rel > 0, half, 0)
    n = jnp.abs(rel)
    nf = jnp.maximum(n, 1).astype(jnp.float32)
    large = max_exact + (jnp.log(nf / max_exact) / math.log(MAX_DISTANCE / max_exact)
                         * (half - max_exact)).astype(jnp.int32)
    large = jnp.minimum(large, half - 1)
    return ret + jnp.where(n < max_exact, n, large)


def forgetting_attention(q, k, v, log_f):
    B, T, H, hd = q.shape
    dcum = jnp.cumsum(log_f, axis=1).transpose(0, 2, 1)
    scale = hd ** -0.5
    outs = []
    for start in range(0, T, FOX_BLOCK):
        end = start + FOX_BLOCK
        s = jnp.einsum('bqhd,bkhd->bhqk', q[:, start:end], k[:, :end],
                       preferred_element_type=jnp.float32) * scale
        decay = dcum[:, :, start:end, None] - dcum[:, :, None, :end]
        qpos = jnp.arange(start, end)[:, None]
        kpos = jnp.arange(end)[None, :]
        s = jnp.where(kpos <= qpos, s + decay, -jnp.inf)
        p = jax.nn.softmax(s, axis=-1).astype(v.dtype)
        outs.append(jnp.einsum('bhqk,bkhd->bqhd', p, v[:, :end]))
    return jnp.concatenate(outs, axis=1)


def dsa_attention(q, k, v, q_idx, k_idx, w_idx, rel_bias, k_top):
    B, T, H, hd = q.shape
    nblk = T // DSA_BLOCK
    cid = chunk_ids(T)
    bidx = jnp.arange(B)[:, None, None]

    def to_blocks(a):
        return a.reshape(B, nblk, DSA_BLOCK, *a.shape[2:]).swapaxes(0, 1)

    def one_block(args):
        qb, qib, wib, start = args
        qpos = start + jnp.arange(DSA_BLOCK)
        dots = jnp.einsum('bqhd,bsd->bqhs', qib, k_idx,
                          preferred_element_type=jnp.float32) * (D_IDX ** -0.5)
        score = jnp.einsum('bqh,bqhs->bqs', wib.astype(jnp.float32) * (H_IDX ** -0.5),
                           jax.nn.relu(dots))
        admissible = cid[None, :] <= cid[qpos][:, None]
        score = jnp.where(admissible[None], score, -jnp.inf)
        top_val, top_idx = lax.top_k(score, k_top)
        valid = jnp.isfinite(top_val)
        ks = k[bidx, top_idx]
        vs = v[bidx, top_idx]
        s = jnp.einsum('bqhd,bqkhd->bhqk', qb, ks,
                       preferred_element_type=jnp.float32) * (hd ** -0.5)
        bucket = t5_bucket(top_idx - qpos[None, :, None])
        bias = rel_bias[bucket].astype(jnp.float32).transpose(0, 3, 1, 2)
        s = jnp.where(valid[:, None], s + bias, -jnp.inf)
        p = jax.nn.softmax(s, axis=-1).astype(v.dtype)
        return jnp.einsum('bhqk,bqkhd->bqhd', p, vs)

    starts = jnp.arange(nblk, dtype=jnp.int32) * DSA_BLOCK
    out = lax.map(one_block, (to_blocks(q), to_blocks(q_idx), to_blocks(w_idx), starts))
    return out.swapaxes(0, 1).reshape(B, T, H, hd)


def setup_inputs(seed: int = 0) -> dict:
    key = jax.random.key(seed)
    ks = jax.random.split(key, 14)
    f32 = jnp.float32
    nrm = lambda k, shape, s: jax.random.normal(k, shape, f32) * s
    return {
        "x": nrm(ks[0], (BATCH, SEQ, D_MODEL), 1.0),
        "meta_tokens": nrm(ks[1], (N_META, D_MODEL), 1.0),
        "attn_norm_g": 1.0 + nrm(ks[2], (DEPTH, D_MODEL), 0.02),
        "w_in": nrm(ks[3], (DEPTH, D_MODEL, D_IN), D_MODEL ** -0.5),
        "forget_bias": 2.0 + nrm(ks[4], (DEPTH, H_FOX), 0.1),
        "rel_bias": nrm(ks[5], (N_BUCKETS, H_DSA), 0.2),
        "w_branch_fox": nrm(ks[6], (DEPTH, W_FOX, D_MODEL), W_FOX ** -0.5),
        "w_branch_dsa": nrm(ks[7], (DEPTH, W_DSA, D_MODEL), W_DSA ** -0.5),
        "w_out": nrm(ks[8], (DEPTH, D_MODEL, D_MODEL), D_MODEL ** -0.5),
        "mlp_norm_g": 1.0 + nrm(ks[9], (DEPTH, D_MODEL), 0.02),
        "w_up": nrm(ks[10], (DEPTH, D_MODEL, D_FF), D_MODEL ** -0.5),
        "w_down": nrm(ks[11], (DEPTH, D_FF, D_MODEL), D_FF ** -0.5),
        "final_norm_g": 1.0 + nrm(ks[12], (D_MODEL,), 0.02),
    }


def reference(x, meta_tokens, attn_norm_g, w_in, forget_bias, rel_bias, w_branch_fox, w_branch_dsa,
              w_out, mlp_norm_g, w_up, w_down, final_norm_g):
    B, L, D = x.shape
    T = N_META + L
    T_pad = -(-T // FOX_BLOCK) * FOX_BLOCK
    meta = jnp.broadcast_to(meta_tokens[None].astype(x.dtype), (B, N_META, D))
    h = jnp.concatenate([meta, x, jnp.zeros((B, T_pad - T, D), x.dtype)], axis=1)
    k_top = min(TOPK_MAX, L // 4)
    split_at = np.cumsum(IN_SPLITS)[:-1].tolist()

    for layer in range(DEPTH):
        u = rmsnorm(h, attn_norm_g[layer])
        proj = u @ w_in[layer]
        qa, ka, va, fa, qb, kb, vb, qi, ki, wi, gl = jnp.split(proj, split_at, axis=-1)
        heads = lambda a, n: a.reshape(B, T_pad, n, -1)
        log_f = jax.nn.log_sigmoid(fa.astype(jnp.float32) + forget_bias[layer].astype(jnp.float32))
        o_fox = forgetting_attention(heads(qa, H_FOX), heads(ka, H_FOX), heads(va, H_FOX), log_f)
        o_dsa = dsa_attention(heads(qb, H_DSA), heads(kb, H_DSA), heads(vb, H_DSA),
                              heads(qi, H_IDX), ki, wi, rel_bias, k_top)
        y_fox = o_fox.reshape(B, T_pad, W_FOX) @ w_branch_fox[layer]
        y_dsa = o_dsa.reshape(B, T_pad, W_DSA) @ w_branch_dsa[layer]
        g = jax.nn.sigmoid(gl.astype(jnp.float32)).astype(h.dtype).reshape(B, T_pad, N_BRANCH, D)
        mixed = g[:, :, 0] * y_fox + g[:, :, 1] * y_dsa
        h = h + mixed @ w_out[layer]
        u = rmsnorm(h, mlp_norm_g[layer])
        h = h + jnp.square(jax.nn.relu(u @ w_up[layer])) @ w_down[layer]

    out = rmsnorm(h, final_norm_g)
    return out[:, N_META:N_META + L]
```

```cpp
#include <hip/hip_runtime.h>
#include <hip/hip_bf16.h>
#include <cstdio>
#include <cstdint>

#define GAS __attribute__((address_space(1)))
#define LAS __attribute__((address_space(3)))
typedef unsigned short bf16;
typedef unsigned v4u __attribute__((ext_vector_type(4)));
typedef float f32x4 __attribute__((ext_vector_type(4)));
typedef float f32x16 __attribute__((ext_vector_type(16)));
typedef short bf16x8 __attribute__((ext_vector_type(8)));
typedef short s16x4 __attribute__((ext_vector_type(4)));
typedef GAS unsigned gu32;
typedef GAS unsigned long long gu64;
typedef unsigned long long u64;
#define RLX_AGENT __ATOMIC_RELAXED, __HIP_MEMORY_SCOPE_AGENT
#define LDS_WAIT() asm volatile("s_waitcnt lgkmcnt(0)" ::: "memory")
#define VM_WAIT() asm volatile("s_waitcnt vmcnt(0)" ::: "memory")
#define SBAR() __builtin_amdgcn_sched_barrier(0)
__device__ __forceinline__ unsigned f2bf(float f) { unsigned u = __builtin_bit_cast(unsigned, f); return (u + 0x7fffu + ((u >> 16) & 1u)) >> 16; }
__device__ __forceinline__ unsigned pk2(float lo, float hi) { return f2bf(lo) | (f2bf(hi) << 16); }
__device__ __forceinline__ unsigned cvtpk(float lo, float hi) { unsigned r; asm volatile("v_cvt_pk_bf16_f32 %0, %1, %2" : "=v"(r) : "v"(lo), "v"(hi)); return r; }
__device__ __forceinline__ float bf2f(unsigned short b) { return __builtin_bit_cast(float, ((unsigned)b) << 16); }

constexpr int DM = 4096, NB = 4, LSEQ = 4096, MROWS = NB * LSEQ, MPAD = MROWS + 256;
constexpr int NMETA = 16, METAROW = MROWS + 48;
constexpr int HD = 128, NH = 16, WBR = NH * HD;
constexpr int HIDX = 32, DIDX = 64, KTOP = 256;
constexpr int DFF = 4 * DM;
constexpr int PP = 7 * 2048;
constexpr int C_QA = 0, C_KA = 2048, C_VA = 4096, C_QB = 6144, C_KB = 8192, C_VB = 10240, C_QI = 12288;
constexpr int NIN_TILES = 89, NIN = NIN_TILES * 256;
constexpr int DIN = 22640;
constexpr float RMS_EPS = 1e-6f;
constexpr float LOG2E = 1.4426950408889634f;
constexpr int NKT = LSEQ / 64 + 1;
constexpr int MASK_PITCH = 68;
constexpr int DL_PITCH = NKT * 64;
constexpr size_t SC_PER_BATCH = (size_t)2048 * 64 * 67;

namespace pg8 {
#define PG8_LAS __attribute__((address_space(3)))
typedef unsigned short bf16_t;
typedef short bf16x8 __attribute__((ext_vector_type(8)));
typedef float f32x4 __attribute__((ext_vector_type(4)));
typedef unsigned u32x4 __attribute__((ext_vector_type(4)));
constexpr int BM = 256, BK = 64, HALF = 128, HTB = HALF * BK * 2  , STAGE_BYTES = 8 * HTB, NXCD = 8, WGM = 8;

__host__ __device__ __forceinline__ int lds_byte(int r, int c) { const int st = (r >> 4) * 2 + (c >> 5), rr = r & 15, cc = c & 31, ob = rr * 64 + cc * 2; return st * 1024 + (ob ^ (((ob >> 9) & 1) << 5)); }
__host__ __device__ __forceinline__ void stage_rc(int b, int& R, int& C) { const int st = b / 1024, sb = b % 1024, swz = sb ^ (((sb >> 9) & 1) << 5); R = (st >> 1) * 16 + swz / 64; C = (st & 1) * 32 + (swz % 64) / 2; }
__host__ __device__ __forceinline__ int perm32(int rho) { const int n = rho >> 4, i = rho & 15; return 8 * (i >> 2) + 4 * n + (i & 3); }

struct Unit { int pm, pn; };
struct Gemm { const bf16_t* A; const bf16_t* Bt; int lda, ldb, K; };

struct StaticOrder {
    int nM, nN, nwg, G, c;
    __host__ __device__ void init(int M, int N, int G_, int c_) { nM = M / BM; nN = N / BM; nwg = nM * nN; G = G_; c = c_; }
    __host__ __device__ __forceinline__ bool next(int i, Unit& u) const {
        const long L = (long)i * G + c; if (L >= nwg) return false;
        int wgid = (int)L; { const int q = nwg / NXCD, r = nwg % NXCD, xcd = wgid % NXCD, off = wgid / NXCD; wgid = (xcd < r ? xcd * (q + 1) : r * (q + 1) + (xcd - r) * q) + off; }
        const int nig = WGM * nN, gid = wgid / nig, fm = gid * WGM, gsz = (nM - fm) < WGM ? (nM - fm) : WGM;
        u.pm = fm + ((wgid % nig) % gsz); u.pn = (wgid % nig) / gsz; return true;
    }
    __device__ __forceinline__ void a_ready(const Unit&) const {}
    __device__ __forceinline__ void done(const Unit&) const {}
};

#ifndef H1_BF16
#define H1_BF16 1
#endif
#ifndef EPI_NT
#define EPI_NT 0
#endif
#if EPI_NT
#define PG8_ST16(p, w) __builtin_nontemporal_store((w), (u32x4*)(p))
#else
#define PG8_ST16(p, w) (*(u32x4*)(p) = (w))
#endif
__device__ __forceinline__ unsigned cvt_pk_bf16(float lo, float hi) { unsigned r; asm volatile("v_cvt_pk_bf16_f32 %0, %1, %2" : "=v"(r) : "v"(lo), "v"(hi)); return r; }
__device__ __forceinline__ unsigned cvt_pk_bf16_t(float lo, float hi) { unsigned r; asm volatile("s_nop 0\n\tv_cvt_pk_bf16_f32 %0, %1, %2" : "=v"(r) : "v"(lo), "v"(hi)); return r; }

#ifndef W_OUT_FP8
#define W_OUT_FP8 1
#endif
#ifndef FP8_QK
#define FP8_QK 1
#endif
__host__ __device__ __forceinline__ constexpr int proj_bf16_tiles() { return FP8_QK ? 9 : 41; }
__host__ __device__ __forceinline__ constexpr int proj_fp8_tiles() { return FP8_QK ? 80 : 48; }
__host__ __device__ __forceinline__ int proj_bf16_tile(int j) { return FP8_QK ? (j < 8 ? 48 + j : 88) : (j < 16 ? j : (j < 32 ? j + 8 : (j < 40 ? j + 16 : 88))); }
__host__ __device__ __forceinline__ int proj_fp8_tile(int j) { return FP8_QK ? (j < 48 ? j : j + 8) : (j < 8 ? 16 + j : (j < 16 ? 32 + j : j + 40)); }
struct ProjOrder : StaticOrder {
    __device__ __forceinline__ bool next(int i, Unit& u) const {
        const long L = (long)i * G + c;
        if (L < nwg) { StaticOrder::next(i, u); u.pn = proj_bf16_tile(u.pn); return true; }
        const int e = (int)(L - nwg); if (e >= 33) return false;
        u.pm = 64; u.pn = e < 16 ? 8 + e : (e < 32 ? 32 + (e - 16) : 88); return true;
    }
};
struct Proj8Order : StaticOrder {
    __device__ __forceinline__ bool next(int i, Unit& u) const { if (!StaticOrder::next(i, u)) return false; u.pn = proj_fp8_tile(u.pn); return true; }
};

template <int PMR> struct PanelOrder : StaticOrder {
    __device__ __forceinline__ bool next(int i, Unit& u) const {
        if (G != 256 || nM != 64 || nN != 16) return StaticOrder::next(i, u);
        constexpr int PNR = 32 / PMR, NPH = 16 / PNR, ROUNDS = 4;
        if (i >= ROUNDS) return false;
        const int xcd = c & 7, r = c >> 3;
        const int slot = i * 8 + xcd;
        const int pgrp = slot / NPH, ph = slot % NPH;
        u.pm = pgrp * PMR + r / PNR; u.pn = ph * PNR + r % PNR; return true;
    }
};
struct UpOrder : StaticOrder {
    __device__ __forceinline__ bool next(int i, Unit& u) const {
        if (G != 256 || nM != 64 || nN != 64) return StaticOrder::next(i, u);
        if (i >= 16) return false;
        const int xcd = c & 7, r = c >> 3, sp = 3 - (i >> 2), j = i & 3;
        u.pm = 16 * sp + 8 * (xcd & 1) + (r & 7); u.pn = 16 * j + 4 * (xcd >> 1) + (r >> 3); return true;
    }
};
struct ProbeOrder : StaticOrder {
    __device__ __forceinline__ bool next(int i, Unit& u) const { const long L = (long)i * G + c; if (L >= nwg) return false; u.pm = 0; u.pn = 0; return true; }
};
struct EpiProj {
    static constexpr bool PERM = true, AFTER_DRAIN = false;
    bf16_t* PROJ; float* LF; bf16_t* KI; float* WI; const float* fbias;
    __device__ __forceinline__ void operator()(const f32x4 (&acc)[2][2][4][2], const Unit& u, int wr, int wc, int fr, int fq) const {
        const int row0 = u.pm * BM + wr * 64 + fr, c8 = wc * 32 + 8 * fq;
        if (u.pn < 88) {
            bf16_t* base = PROJ + (size_t)u.pn * BM + c8;
            const size_t ldc = 14336;
#pragma unroll
            for (int ai = 0; ai < 2; ++ai)
#pragma unroll
                for (int m = 0; m < 4; ++m) { bf16_t* rowp = base + (size_t)(row0 + ai * HALF + m * 16) * ldc;
#pragma unroll
                    for (int bj = 0; bj < 2; ++bj) { f32x4 v0 = acc[ai][bj][m][0], v1 = acc[ai][bj][m][1];
                        u32x4 w; w.x = cvt_pk_bf16(v0[0], v0[1]); w.y = cvt_pk_bf16(v0[2], v0[3]); w.z = cvt_pk_bf16(v1[0], v1[1]); w.w = cvt_pk_bf16(v1[2], v1[3]);
                        *(u32x4*)(rowp + bj * HALF) = w; } }
        } else {
#pragma unroll
            for (int ai = 0; ai < 2; ++ai)
#pragma unroll
                for (int m = 0; m < 4; ++m) { const size_t row = (size_t)(row0 + ai * HALF + m * 16); const f32x4 v0 = acc[ai][0][m][0], v1 = acc[ai][0][m][1];
                    if (c8 < 16) { f32x4 o0, o1;
#pragma unroll
                        for (int j = 0; j < 4; ++j) { const float z0 = v0[j] + fbias[c8 + j], z1 = v1[j] + fbias[c8 + 4 + j];
                            o0[j] = fminf(z0, 0.f) - log1pf(expf(-fabsf(z0))); o1[j] = fminf(z1, 0.f) - log1pf(expf(-fabsf(z1))); }
                        *(f32x4*)(LF + row * 16 + c8) = o0; *(f32x4*)(LF + row * 16 + c8 + 4) = o1; }
                    else if (c8 < 80) { u32x4 w; w.x = cvt_pk_bf16(v0[0], v0[1]); w.y = cvt_pk_bf16(v0[2], v0[3]); w.z = cvt_pk_bf16(v1[0], v1[1]); w.w = cvt_pk_bf16(v1[2], v1[3]);
                        *(u32x4*)(KI + row * 64 + (c8 - 16)) = w; }
                    else if (c8 < 112) { *(f32x4*)(WI + row * 32 + (c8 - 80)) = v0; *(f32x4*)(WI + row * 32 + (c8 - 80) + 4) = v1; } }
        }
    }
};
struct EpiProj8 {
    static constexpr bool PERM = true, AFTER_DRAIN = false;
    bf16_t* PROJ; bf16_t* G;
    __device__ __forceinline__ void operator()(const f32x4 (&acc)[2][2][4][2], const Unit& u, int wr, int wc, int fr, int fq) const {
        const int row0 = u.pm * BM + wr * 64 + fr, c8 = wc * 32 + 8 * fq;
        const bool gate = u.pn >= 56;
        bf16_t* base = gate ? G + (size_t)(u.pn - 56) * BM + c8 : PROJ + (size_t)u.pn * BM + c8;
        const size_t ldc = gate ? 8192 : 14336;
#pragma unroll
        for (int ai = 0; ai < 2; ++ai)
#pragma unroll
            for (int m = 0; m < 4; ++m) { bf16_t* rowp = base + (size_t)(row0 + ai * HALF + m * 16) * ldc;
#pragma unroll
                for (int bj = 0; bj < 2; ++bj) { f32x4 v0 = acc[ai][bj][m][0], v1 = acc[ai][bj][m][1];
                    if (gate) {
#pragma unroll
                        for (int j = 0; j < 4; ++j) { v0[j] = __builtin_amdgcn_rcpf(1.0f + __builtin_amdgcn_exp2f((-1.4426950408889634f / 64.f) * v0[j])); v1[j] = __builtin_amdgcn_rcpf(1.0f + __builtin_amdgcn_exp2f((-1.4426950408889634f / 64.f) * v1[j])); }
                    } else {
#pragma unroll
                        for (int j = 0; j < 4; ++j) { v0[j] *= (1.f / 64.f); v1[j] *= (1.f / 64.f); } }
                    u32x4 w; w.x = cvt_pk_bf16_t(v0[0], v0[1]); w.y = cvt_pk_bf16_t(v0[2], v0[3]); w.z = cvt_pk_bf16_t(v1[0], v1[1]); w.w = cvt_pk_bf16_t(v1[2], v1[3]);
                    PG8_ST16(rowp + bj * HALF, w); } }
    }
};
template <bool FIRST> struct EpiGate {
    static constexpr bool PERM = true, AFTER_DRAIN = false;
    bf16_t* MIX; const bf16_t* G; int gcol; unsigned char* M8; float asc;
    __device__ __forceinline__ void operator()(const f32x4 (&acc)[2][2][4][2], const Unit& u, int wr, int wc, int fr, int fq) const {
        const int row0 = u.pm * BM + wr * 64 + fr, col0 = u.pn * BM + wc * 32 + 8 * fq;
#pragma unroll
        for (int ai = 0; ai < 2; ++ai)
#pragma unroll
            for (int m = 0; m < 4; ++m) { const size_t row = (size_t)(row0 + ai * HALF + m * 16);
#pragma unroll
                for (int bj = 0; bj < 2; ++bj) { const int col = col0 + bj * HALF;
                    const u32x4 gv = *(const u32x4*)(G + row * 8192 + gcol + col);
                    f32x4 v0 = acc[ai][bj][m][0] * asc, v1 = acc[ai][bj][m][1] * asc;
                    v0[0] *= __builtin_bit_cast(float, gv.x << 16); v0[1] *= __builtin_bit_cast(float, gv.x & 0xffff0000u); v0[2] *= __builtin_bit_cast(float, gv.y << 16); v0[3] *= __builtin_bit_cast(float, gv.y & 0xffff0000u);
                    v1[0] *= __builtin_bit_cast(float, gv.z << 16); v1[1] *= __builtin_bit_cast(float, gv.z & 0xffff0000u); v1[2] *= __builtin_bit_cast(float, gv.w << 16); v1[3] *= __builtin_bit_cast(float, gv.w & 0xffff0000u);
                    if (!FIRST) { const u32x4 pv = *(const u32x4*)(MIX + row * 4096 + col);
                        v0[0] += __builtin_bit_cast(float, pv.x << 16); v0[1] += __builtin_bit_cast(float, pv.x & 0xffff0000u); v0[2] += __builtin_bit_cast(float, pv.y << 16); v0[3] += __builtin_bit_cast(float, pv.y & 0xffff0000u);
                        v1[0] += __builtin_bit_cast(float, pv.z << 16); v1[1] += __builtin_bit_cast(float, pv.z & 0xffff0000u); v1[2] += __builtin_bit_cast(float, pv.w << 16); v1[3] += __builtin_bit_cast(float, pv.w & 0xffff0000u); }
                    if (!FIRST && W_OUT_FP8) { int lo = 0, hi = 0;
                        lo = __builtin_amdgcn_cvt_pk_fp8_f32(16.f * v0[0], 16.f * v0[1], lo, false); lo = __builtin_amdgcn_cvt_pk_fp8_f32(16.f * v0[2], 16.f * v0[3], lo, true);
                        hi = __builtin_amdgcn_cvt_pk_fp8_f32(16.f * v1[0], 16.f * v1[1], hi, false); hi = __builtin_amdgcn_cvt_pk_fp8_f32(16.f * v1[2], 16.f * v1[3], hi, true);
                        *(unsigned long long*)(M8 + row * 4096 + col) = (unsigned long long)(unsigned)lo | ((unsigned long long)(unsigned)hi << 32); }
                    else { u32x4 w; w.x = cvt_pk_bf16(v0[0], v0[1]); w.y = cvt_pk_bf16(v0[2], v0[3]); w.z = cvt_pk_bf16(v1[0], v1[1]); w.w = cvt_pk_bf16(v1[2], v1[3]);
                        *(u32x4*)(MIX + row * 4096 + col) = w; } } }
    }
};
struct EpiResid {
    static constexpr bool PERM = false, AFTER_DRAIN = false;
    const float* base; float* out; int ldc;
    __device__ __forceinline__ void operator()(const f32x4 (&acc)[2][2][4][2], const Unit& u, int wr, int wc, int fr, int fq) const {
        const int row0 = u.pm * BM + wr * 64 + fr, col0 = u.pn * BM + wc * 32 + 4 * fq;
#pragma unroll
        for (int ai = 0; ai < 2; ++ai)
#pragma unroll
            for (int m = 0; m < 4; ++m) { const size_t off = (size_t)(row0 + ai * HALF + m * 16) * ldc + col0;
#pragma unroll
                for (int bj = 0; bj < 2; ++bj)
#pragma unroll
                    for (int n = 0; n < 2; ++n) { const f32x4 b = *(const f32x4*)(base + off + bj * HALF + n * 16); *(f32x4*)(out + off + bj * HALF + n * 16) = acc[ai][bj][m][n] + b; } }
    }
};
struct EpiResidB {
    static constexpr bool PERM = false, AFTER_DRAIN = false;
    const bf16_t* base; float* out; int ldc;
    __device__ __forceinline__ void operator()(const f32x4 (&acc)[2][2][4][2], const Unit& u, int wr, int wc, int fr, int fq) const {
        const int row0 = u.pm * BM + wr * 64 + fr, col0 = u.pn * BM + wc * 32 + 4 * fq;
#pragma unroll
        for (int ai = 0; ai < 2; ++ai)
#pragma unroll
            for (int m = 0; m < 4; ++m) { const size_t off = (size_t)(row0 + ai * HALF + m * 16) * ldc + col0;
#pragma unroll
                for (int bj = 0; bj < 2; ++bj)
#pragma unroll
                    for (int n = 0; n < 2; ++n) { const unsigned long long b = *(const unsigned long long*)(base + off + bj * HALF + n * 16);
                        const f32x4 bf = {__builtin_bit_cast(float, (unsigned)b << 16), __builtin_bit_cast(float, (unsigned)b & 0xffff0000u), __builtin_bit_cast(float, (unsigned)(b >> 32) << 16), __builtin_bit_cast(float, (unsigned)(b >> 32) & 0xffff0000u)};
                        *(f32x4*)(out + off + bj * HALF + n * 16) = acc[ai][bj][m][n] + bf; } }
    }
};
struct EpiResidNorm {
    static constexpr bool PERM = true, AFTER_DRAIN = false;
    const float* base; float* out; bf16_t* A2; const float* gain; float* PS; int ldc; float asc;
    __device__ __forceinline__ void operator()(const f32x4 (&acc)[2][2][4][2], const Unit& u, int wr, int wc, int fr, int fq) const {
        const int row0 = u.pm * BM + wr * 64 + fr, col0 = u.pn * BM + wc * 32 + 8 * fq;
        f32x4 gv[2][2];
#pragma unroll
        for (int bj = 0; bj < 2; ++bj) { gv[bj][0] = *(const f32x4*)(gain + col0 + bj * HALF); gv[bj][1] = *(const f32x4*)(gain + col0 + bj * HALF + 4); }
#pragma unroll
        for (int ai = 0; ai < 2; ++ai)
#pragma unroll
            for (int m = 0; m < 4; ++m) { const size_t row = (size_t)(row0 + ai * HALF + m * 16); float ss = 0.f;
#pragma unroll
                for (int bj = 0; bj < 2; ++bj) { const size_t off = row * ldc + col0 + bj * HALF;
                    const f32x4 h0 = acc[ai][bj][m][0] * asc + *(const f32x4*)(base + off), h1 = acc[ai][bj][m][1] * asc + *(const f32x4*)(base + off + 4);
                    if (!H1_BF16) { *(f32x4*)(out + off) = h0; *(f32x4*)(out + off + 4) = h1; }
                    ss += (h0[0] * h0[0] + h0[1] * h0[1]) + (h0[2] * h0[2] + h0[3] * h0[3]) + (h1[0] * h1[0] + h1[1] * h1[1]) + (h1[2] * h1[2] + h1[3] * h1[3]);
                    const f32x4 a0 = H1_BF16 ? h0 : h0 * gv[bj][0], a1 = H1_BF16 ? h1 : h1 * gv[bj][1];
                    u32x4 w; w.x = cvt_pk_bf16(a0[0], a0[1]); w.y = cvt_pk_bf16(a0[2], a0[3]); w.z = cvt_pk_bf16(a1[0], a1[1]); w.w = cvt_pk_bf16(a1[2], a1[3]);
                    *(u32x4*)(A2 + off) = w; }
                ss += __shfl_xor(ss, 16); ss += __shfl_xor(ss, 32);
                if (fq == 0) PS[row * 64 + u.pn * 4 + wc] = ss; }
    }
};
struct EpiRelu2Scaled {
    static constexpr bool PERM = true, AFTER_DRAIN = false;
    bf16_t* O; int ldc; const float* RS2;
    __device__ __forceinline__ void operator()(const f32x4 (&acc)[2][2][4][2], const Unit& u, int wr, int wc, int fr, int fq) const {
        const int row0 = u.pm * BM + wr * 64 + fr, col0 = u.pn * BM + wc * 32 + 8 * fq;
#pragma unroll
        for (int ai = 0; ai < 2; ++ai)
#pragma unroll
            for (int m = 0; m < 4; ++m) { const int row = row0 + ai * HALF + m * 16; const float s2 = RS2[row]; bf16_t* rowp = O + (size_t)row * ldc + col0;
#pragma unroll
                for (int bj = 0; bj < 2; ++bj) { f32x4 v0 = acc[ai][bj][m][0], v1 = acc[ai][bj][m][1];
#pragma unroll
                    for (int j = 0; j < 4; ++j) { const float a = fmaxf(v0[j], 0.f), b = fmaxf(v1[j], 0.f); v0[j] = a * a * s2; v1[j] = b * b * s2; }
                    u32x4 w; w.x = cvt_pk_bf16(v0[0], v0[1]); w.y = cvt_pk_bf16(v0[2], v0[3]); w.z = cvt_pk_bf16(v1[0], v1[1]); w.w = cvt_pk_bf16(v1[2], v1[3]);
                    PG8_ST16(rowp + bj * HALF, w); } }
    }
};
struct EpiRelu2 {
    static constexpr bool PERM = true, AFTER_DRAIN = false;
    bf16_t* O; int ldc;
    __device__ __forceinline__ void operator()(const f32x4 (&acc)[2][2][4][2], const Unit& u, int wr, int wc, int fr, int fq) const {
        const int row0 = u.pm * BM + wr * 64 + fr, col0 = u.pn * BM + wc * 32 + 8 * fq;
#pragma unroll
        for (int ai = 0; ai < 2; ++ai)
#pragma unroll
            for (int m = 0; m < 4; ++m) { bf16_t* rowp = O + (size_t)(row0 + ai * HALF + m * 16) * ldc + col0;
#pragma unroll
                for (int bj = 0; bj < 2; ++bj) { f32x4 v0 = acc[ai][bj][m][0], v1 = acc[ai][bj][m][1];
#pragma unroll
                    for (int j = 0; j < 4; ++j) { const float a = fmaxf(v0[j], 0.f), b = fmaxf(v1[j], 0.f); v0[j] = a * a; v1[j] = b * b; }
                    u32x4 w; w.x = cvt_pk_bf16(v0[0], v0[1]); w.y = cvt_pk_bf16(v0[2], v0[3]); w.z = cvt_pk_bf16(v1[0], v1[1]); w.w = cvt_pk_bf16(v1[2], v1[3]);
                    *(u32x4*)(rowp + bj * HALF) = w; } }
    }
};

template <class Epi, class Sched, bool ALIGN_EPI = false, bool SP2 = false, int EPIREP = 1, int PROBE = 0, bool FP8 = false>
__device__ __forceinline__ void gemm_phase(PG8_LAS unsigned char* lds, const Gemm g, const Sched& S, const Epi& E) {
    const int tid = threadIdx.x, wid = __builtin_amdgcn_readfirstlane(tid >> 6), lane = tid & 63, wr = wid >> 2, wc = wid & 3, fr = lane & 15, fq = lane >> 4;
    const int K = g.K, nt = K / BK;
    unsigned voffA[2], voffB[2];
#pragma unroll
    for (int i = 0; i < 2; ++i) { int R, C; stage_rc(tid * 16 + i * 8192, R, C); const int Rb = Epi::PERM ? ((R & ~31) + perm32(R & 31)) : R;
        voffA[i] = (unsigned)(R * g.lda + C) * 2u; voffB[i] = (unsigned)(Rb * g.ldb + C) * 2u; }
    const size_t kstep = (size_t)(BK * 2);
    const size_t hstepA = (size_t)HALF * g.lda * 2, hstepB = (size_t)HALF * g.ldb * 2;
    const size_t tstepA = 2 * hstepA, tstepB = 2 * hstepB;
    const size_t qs_voffA = (size_t)64 * g.lda * 2, qs_voffB = (size_t)64 * g.ldb * 2;
    const unsigned ldsw = (unsigned)wid * 1024u;
    int aoff = lds_byte(wr * 64 + fr, fq * 8), boff = lds_byte(wc * 32 + fr, fq * 8);
#define PG8_SA(b, h) (((b) * 2 + (h)) * HTB)
#define PG8_SB(b, h) ((4 + (b) * 2 + (h)) * HTB)
#define PG8_STAGE(bufoff, gbase, voff) do { if (PROBE == 1) break; _Pragma("unroll") for (int _i = 0; _i < 2; ++_i) \
        __builtin_amdgcn_global_load_lds((const unsigned*)((const char*)(gbase) + (FP8 ? (size_t)_i * qs_##voff : (size_t)0) + (voff)[FP8 ? 0 : _i]), (PG8_LAS unsigned*)(lds + (bufoff) + ldsw + _i * 8192), 16, 0, 0); } while (0)
#define PG8_LDA(dst, b, h) do { if (PROBE == 1) { asm volatile("" : "+v"(dst[0][0]), "+v"(dst[1][0]), "+v"(dst[2][1]), "+v"(dst[3][1])); break; } _Pragma("unroll") for (int m = 0; m < 4; ++m) _Pragma("unroll") for (int k = 0; k < 2; ++k) dst[m][k] = *(const PG8_LAS bf16x8*)(lds + PG8_SA(b, h) + aoff + m * 2048 + k * 1024); } while (0)
#define PG8_LDB(dst, b, h) do { if (PROBE == 1) { asm volatile("" : "+v"(dst[0][0]), "+v"(dst[1][1])); break; } _Pragma("unroll") for (int n = 0; n < 2; ++n) _Pragma("unroll") for (int k = 0; k < 2; ++k) dst[n][k] = *(const PG8_LAS bf16x8*)(lds + PG8_SB(b, h) + boff + n * 2048 + k * 1024); } while (0)
#define PG8_MMA(ai, bj, At, Bt) do { __builtin_amdgcn_s_setprio(1); _Pragma("unroll") for (int m = 0; m < 4; ++m) _Pragma("unroll") for (int n = 0; n < 2; ++n) { \
        if constexpr (FP8) { typedef int i32x4_ __attribute__((ext_vector_type(4))); typedef int i32x8_ __attribute__((ext_vector_type(8)));                        \
            const i32x8_ a8_ = __builtin_shufflevector(__builtin_bit_cast(i32x4_, At[m][0]), __builtin_bit_cast(i32x4_, At[m][1]), 0, 1, 2, 3, 4, 5, 6, 7);          \
            const i32x8_ b8_ = __builtin_shufflevector(__builtin_bit_cast(i32x4_, Bt[n][0]), __builtin_bit_cast(i32x4_, Bt[n][1]), 0, 1, 2, 3, 4, 5, 6, 7);          \
            asm volatile("v_mfma_scale_f32_16x16x128_f8f6f4 %0, %1, %2, %0, %3, %3 op_sel_hi:[0,0,0]" : "+v"(acc[ai][bj][m][n]) : "v"(b8_), "v"(a8_), "v"(sc8_)); }   \
        else { _Pragma("unroll") for (int k = 0; k < 2; ++k) acc[ai][bj][m][n] = __builtin_amdgcn_mfma_f32_16x16x32_bf16(Bt[n][k], At[m][k], acc[ai][bj][m][n], 0, 0, 0); } } \
        __builtin_amdgcn_s_setprio(0); } while (0)
#define PG8_WAIT_V(n) do { if (PROBE != 1) asm volatile("s_waitcnt vmcnt(" #n ")" ::: "memory"); } while (0)
#define PG8_WAIT_L(n) do { if (PROBE != 1) asm volatile("s_waitcnt lgkmcnt(" #n ")" ::: "memory"); } while (0)
#define PG8_BAR __builtin_amdgcn_s_barrier()
#define PG8_SCHED __builtin_amdgcn_sched_barrier(0)
#ifndef PG8_DRAIN_NOPS
#define PG8_DRAIN_NOPS 0
#endif
#define PG8_DRAIN do { if constexpr (FP8 && PG8_DRAIN_NOPS > 0) { _Pragma("unroll") for (int _d = 0; _d < PG8_DRAIN_NOPS; ++_d) asm volatile("s_nop 15" ::: "memory"); } } while (0)
    Unit cur, nxt; int ui = 0;
    if (!S.next(0, cur)) return;
    int sc8_ = 0x7f7f7f7f; if constexpr (FP8) { asm volatile("" : "+v"(sc8_)); }
    f32x4 acc[2][2][4][2];
#pragma unroll
    for (int a = 0; a < 2; ++a)
#pragma unroll
        for (int b = 0; b < 2; ++b)
#pragma unroll
            for (int m = 0; m < 4; ++m)
#pragma unroll
                for (int n = 0; n < 2; ++n) acc[a][b][m][n] = (f32x4){0.f, 0.f, 0.f, 0.f};
    bf16x8 At[4][2], B0[2][2], B1[2][2];
    if (PROBE == 1) {
        unsigned hsh = (unsigned)(tid * 2654435761u);
#pragma unroll
        for (int m = 0; m < 4; ++m)
#pragma unroll
            for (int k = 0; k < 2; ++k)
#pragma unroll
                for (int e = 0; e < 8; ++e) { hsh = hsh * 1664525u + 1013904223u; At[m][k][e] = (short)(0x3f00u | ((hsh >> 16) & 0x80ffu)); }
#pragma unroll
        for (int n = 0; n < 2; ++n)
#pragma unroll
            for (int k = 0; k < 2; ++k)
#pragma unroll
                for (int e = 0; e < 8; ++e) { hsh = hsh * 1664525u + 1013904223u; B0[n][k][e] = (short)(0x3f00u | ((hsh >> 16) & 0x80ffu)); hsh = hsh * 1664525u + 1013904223u; B1[n][k][e] = (short)(0x3f00u | ((hsh >> 16) & 0x80ffu)); }
    }
    const char* cA = (const char*)g.A + (size_t)cur.pm * tstepA; const char* cB = (const char*)g.Bt + (size_t)cur.pn * tstepB;
    S.a_ready(cur);
    if constexpr (SP2) {
        PG8_STAGE(PG8_SB(0, 0), cB, voffB); PG8_STAGE(PG8_SB(0, 1), cB + hstepB, voffB); PG8_STAGE(PG8_SA(0, 0), cA, voffA); PG8_STAGE(PG8_SA(0, 1), cA + hstepA, voffA);
        if (wr == 1) PG8_BAR;
        PG8_WAIT_V(2); PG8_BAR;
        PG8_STAGE(PG8_SB(1, 0), cB + kstep, voffB); PG8_STAGE(PG8_SA(1, 0), cA + kstep, voffA); PG8_STAGE(PG8_SB(1, 1), cB + hstepB + kstep, voffB);
        PG8_WAIT_V(6); PG8_BAR;
    } else {
        PG8_STAGE(PG8_SB(0, 0), cB, voffB); PG8_STAGE(PG8_SA(0, 0), cA, voffA); PG8_STAGE(PG8_SB(0, 1), cB + hstepB, voffB); PG8_STAGE(PG8_SA(0, 1), cA + hstepA, voffA);
        if (wr == 1) PG8_BAR;
        PG8_WAIT_V(4); PG8_BAR;
        PG8_STAGE(PG8_SB(1, 0), cB + kstep, voffB); PG8_STAGE(PG8_SA(1, 0), cA + kstep, voffA); PG8_STAGE(PG8_SB(1, 1), cB + hstepB + kstep, voffB);
        PG8_WAIT_V(6); PG8_BAR;
    }
    for (;;) {
        const bool has_next = S.next(ui + 1, nxt);
        const char* nA = has_next ? (const char*)g.A + (size_t)nxt.pm * tstepA : cA; const char* nB = has_next ? (const char*)g.Bt + (size_t)nxt.pn * tstepB : cB;
        for (int t = 0; t < nt; t += 2) {
            if constexpr (FP8) { asm volatile("" : "+v"(aoff), "+v"(boff), "+v"(voffA[0]), "+v"(voffB[0])); }
            const bool last = (t == nt - 2);
            const char* a1 = cA + (size_t)(t + 1) * kstep;
            const char* a2 = last ? nA : cA + (size_t)(t + 2) * kstep; const char* b2 = last ? nB : cB + (size_t)(t + 2) * kstep;
            const char* a3 = a2 + kstep; const char* b3 = b2 + kstep;
            if (last && has_next) S.a_ready(nxt);
            if constexpr (SP2) {
            PG8_LDB(B0, 0, 0); PG8_LDB(B1, 0, 1); PG8_SCHED; PG8_LDA(At, 0, 0); PG8_STAGE(PG8_SA(1, 1), a1 + hstepA, voffA);
            PG8_WAIT_V(8); PG8_WAIT_L(0); PG8_BAR; PG8_MMA(0, 0, At, B0); PG8_MMA(0, 1, At, B1); PG8_BAR; PG8_DRAIN; PG8_SCHED;
            PG8_LDA(At, 0, 1); PG8_STAGE(PG8_SB(0, 0), b2, voffB); PG8_STAGE(PG8_SB(0, 1), b2 + hstepB, voffB); PG8_STAGE(PG8_SA(0, 0), a2, voffA);
            PG8_WAIT_V(8); PG8_WAIT_L(0); PG8_BAR; PG8_MMA(1, 0, At, B0); PG8_MMA(1, 1, At, B1); PG8_BAR; PG8_DRAIN; PG8_SCHED;
            PG8_LDB(B0, 1, 0); PG8_LDB(B1, 1, 1); PG8_SCHED; PG8_LDA(At, 1, 0); PG8_STAGE(PG8_SA(0, 1), a2 + hstepA, voffA);
            PG8_WAIT_V(8); PG8_WAIT_L(0); PG8_BAR; PG8_MMA(0, 0, At, B0); PG8_MMA(0, 1, At, B1); PG8_BAR; PG8_DRAIN; PG8_SCHED;
            PG8_LDA(At, 1, 1); PG8_STAGE(PG8_SB(1, 0), b3, voffB); PG8_STAGE(PG8_SB(1, 1), b3 + hstepB, voffB); PG8_STAGE(PG8_SA(1, 0), a3, voffA);
            PG8_WAIT_V(8); PG8_WAIT_L(0); PG8_BAR; PG8_MMA(1, 0, At, B0); PG8_MMA(1, 1, At, B1); PG8_BAR; PG8_DRAIN; PG8_SCHED;
            } else {
            PG8_LDB(B0, 0, 0); PG8_SCHED; PG8_LDA(At, 0, 0); PG8_STAGE(PG8_SA(1, 1), a1 + hstepA, voffA);
            PG8_WAIT_L(8); PG8_BAR; PG8_WAIT_L(0); PG8_MMA(0, 0, At, B0); PG8_BAR; PG8_SCHED;
            PG8_LDB(B1, 0, 1); PG8_STAGE(PG8_SB(0, 0), b2, voffB);
            PG8_BAR; PG8_WAIT_L(0); PG8_MMA(0, 1, At, B1); PG8_BAR;
            PG8_LDA(At, 0, 1); PG8_STAGE(PG8_SA(0, 0), a2, voffA);
            PG8_BAR; PG8_WAIT_L(0); PG8_MMA(1, 0, At, B0); PG8_BAR; PG8_SCHED;
            PG8_STAGE(PG8_SB(0, 1), b2 + hstepB, voffB);
            PG8_WAIT_V(6); PG8_BAR; PG8_MMA(1, 1, At, B1); PG8_BAR;
            PG8_LDB(B0, 1, 0); PG8_SCHED; PG8_LDA(At, 1, 0); PG8_STAGE(PG8_SA(0, 1), a2 + hstepA, voffA);
            PG8_WAIT_L(8); PG8_BAR; PG8_WAIT_L(0); PG8_MMA(0, 0, At, B0); PG8_BAR; PG8_SCHED;
            PG8_LDB(B1, 1, 1); PG8_STAGE(PG8_SB(1, 0), b3, voffB);
            PG8_BAR; PG8_WAIT_L(0); PG8_MMA(0, 1, At, B1); PG8_BAR;
            PG8_LDA(At, 1, 1); PG8_STAGE(PG8_SA(1, 0), a3, voffA);
            PG8_BAR; PG8_WAIT_L(0); PG8_MMA(1, 0, At, B0); PG8_BAR; PG8_SCHED;
            PG8_STAGE(PG8_SB(1, 1), b3 + hstepB, voffB);
            PG8_WAIT_V(6); PG8_BAR; PG8_MMA(1, 1, At, B1); PG8_BAR;
            }
        }
        if constexpr (FP8) { asm volatile("s_nop 15" ::: "memory"); }
        if constexpr (ALIGN_EPI) { if (wr == 0) PG8_BAR; }
        if constexpr (!Epi::AFTER_DRAIN) { int fr_ = fr, fq_ = fq; if constexpr (FP8) { int l_ = threadIdx.x; asm volatile("" : "+v"(l_)); fr_ = l_ & 15; fq_ = (l_ >> 4) & 3; }
            E(acc, cur, wr, wc, fr_, fq_); if constexpr (EPIREP > 1) { asm volatile("" ::: "memory"); E(acc, cur, wr, wc, fr_, fq_); } S.done(cur); }
        if (!has_next) break;
#pragma unroll
        for (int a = 0; a < 2; ++a)
#pragma unroll
            for (int b = 0; b < 2; ++b)
#pragma unroll
                for (int m = 0; m < 4; ++m)
#pragma unroll
                    for (int n = 0; n < 2; ++n) acc[a][b][m][n] = (f32x4){0.f, 0.f, 0.f, 0.f};
        cur = nxt; cA = nA; cB = nB; ++ui;
        if constexpr (ALIGN_EPI) { if (wr == 1) PG8_BAR; }
    }
    PG8_WAIT_V(0);
    if constexpr (!ALIGN_EPI) { if (wr == 0) PG8_BAR; }
    PG8_BAR;
    if constexpr (Epi::AFTER_DRAIN) { E.fused(acc, cur, wr, wc, fr, fq, lds, wid, lane); S.done(cur); }
#undef PG8_SA
#undef PG8_SB
#undef PG8_STAGE
#undef PG8_LDA
#undef PG8_LDB
#undef PG8_MMA
#undef PG8_WAIT_V
#undef PG8_WAIT_L
#undef PG8_BAR
#undef PG8_SCHED
#undef PG8_DRAIN
}
}


namespace att {
constexpr int QBLK = 32, KVBLK = 64, QB = 256, SHM_V = KVBLK * HD * 2, SHM_K = KVBLK * HD * 2;
constexpr int LDS_WS = 2 * SHM_V + 2 * SHM_K, LDS_AUX = LDS_WS + 8 * 64 * 4, LDS_FLAGS = LDS_AUX + DL_PITCH * 4, ATT_LDS_BYTES = LDS_FLAGS + 64;
constexpr float C2 = 0.08838834764831845f * LOG2E;
constexpr float THRL = 8.0f;
constexpr float SKIP_MARGIN = 40.0f;
#define KSWZ(row, colB) ((row) * 256 + ((colB) ^ (((row) & 7) << 4)))
__device__ __forceinline__ int v_st(int k, int c) { const int kk = (k & ~0xC) | ((k & 4) << 1) | ((k & 8) >> 1); return ((kk >> 3) * 4 + (c >> 5)) * 512 + ((kk & 7) * 32 + (c & 31)) * 2; }
__device__ __forceinline__ int v_rd_base(int lane) { return ((lane & 3) << 3) | (((lane >> 2) & 3) << 6) | (((lane >> 4) & 1) << 5) | (((lane >> 5) & 1) << 8); }
constexpr int v_rd_off(int d0, int ks, int half) { return d0 * 512 + ks * 4096 + half * 2048; }
__device__ __forceinline__ int crow(int r, int hi) { return (r & 3) + 8 * (r >> 2) + 4 * hi; }

template <int KB>
__device__ __forceinline__ void qkt(f32x16& p0, f32x16& p1, const LAS char* K_lds, int r32, int hi, const bf16x8* qr) {
    p0 = f32x16{}; p1 = f32x16{};
    const LAS char* kb[4];
#pragma unroll
    for (int dd = 0; dd < 4; ++dd) kb[dd] = K_lds + KB * SHM_K + KSWZ(r32, (dd * 16 + hi * 8) * 2);
#pragma unroll
    for (int d0 = 0; d0 < 8; ++d0) { const LAS char* a = kb[d0 & 3] + (d0 >> 2) * 128;
        bf16x8 b0 = *(const LAS bf16x8*)(a);
        bf16x8 b1 = *(const LAS bf16x8*)(a + 32 * 256);
        p0 = __builtin_amdgcn_mfma_f32_32x32x16_bf16(b0, qr[d0], p0, 0, 0, 0);
        p1 = __builtin_amdgcn_mfma_f32_32x32x16_bf16(b1, qr[d0], p1, 0, 0, 0);
        if (d0 == 3) SBAR(); }
}
template <int VB>
__device__ __forceinline__ void pv_tile(f32x16* o, int vb0, bf16x8 pa0, bf16x8 pa1, bf16x8 pa2, bf16x8 pa3) {
#define TRRD(dst, off) asm volatile("ds_read_b64_tr_b16 %0, %1 offset:%2" : "=&v"(dst) : "v"(vb0), "i"(off) : "memory")
#define PV_D0(d0) do { s16x4 l0, l1, l2, l3, h0, h1, h2, h3; constexpr int b_ = VB * SHM_V + v_rd_off(d0, 0, 0);     \
        TRRD(l0, b_); TRRD(h0, b_ + 2048); TRRD(l1, b_ + 4096); TRRD(h1, b_ + 6144); TRRD(l2, b_ + 8192); TRRD(h2, b_ + 10240); TRRD(l3, b_ + 12288); TRRD(h3, b_ + 14336); \
        asm volatile("s_waitcnt lgkmcnt(0)" ::: "memory"); SBAR();                 \
        o[d0] = __builtin_amdgcn_mfma_f32_32x32x16_bf16(pa0, (bf16x8){l0[0], l0[1], l0[2], l0[3], h0[0], h0[1], h0[2], h0[3]}, o[d0], 0, 0, 0);   \
        o[d0] = __builtin_amdgcn_mfma_f32_32x32x16_bf16(pa1, (bf16x8){l1[0], l1[1], l1[2], l1[3], h1[0], h1[1], h1[2], h1[3]}, o[d0], 0, 0, 0);   \
        o[d0] = __builtin_amdgcn_mfma_f32_32x32x16_bf16(pa2, (bf16x8){l2[0], l2[1], l2[2], l2[3], h2[0], h2[1], h2[2], h2[3]}, o[d0], 0, 0, 0);   \
        o[d0] = __builtin_amdgcn_mfma_f32_32x32x16_bf16(pa3, (bf16x8){l3[0], l3[1], l3[2], l3[3], h3[0], h3[1], h3[2], h3[3]}, o[d0], 0, 0, 0); } while (0)
    PV_D0(0); PV_D0(1); PV_D0(2); PV_D0(3);
#undef PV_D0
#undef TRRD
}
__device__ __forceinline__ void partialSM(f32x16& p0, f32x16& p1, float& m_reg, float& alpha) {
    float pmax = p0[0];
#pragma unroll
    for (int r = 1; r < 16; ++r) pmax = fmaxf(pmax, p0[r]);
#pragma unroll
    for (int r = 0; r < 16; ++r) pmax = fmaxf(pmax, p1[r]);
    { auto rr = __builtin_amdgcn_permlane32_swap(__float_as_uint(pmax), __float_as_uint(pmax), false, false);
      pmax = fmaxf(__uint_as_float(rr[0]), __uint_as_float(rr[1])); }
    float mn;
    if (__builtin_expect(__all((pmax - m_reg) <= THRL), 1)) { mn = m_reg; alpha = 1.f; }
    else { mn = fmaxf(m_reg, pmax); alpha = __builtin_amdgcn_exp2f(m_reg - mn); m_reg = mn; }
#pragma unroll
    for (int r = 0; r < 16; ++r) { p0[r] = __builtin_amdgcn_exp2f(p0[r] - mn); p1[r] = p1[r] - mn; }
}
__device__ __forceinline__ void finishSM(f32x16& p0, f32x16& p1, float alpha, float& l_reg, bf16x8& pa0, bf16x8& pa1, bf16x8& pa2, bf16x8& pa3) {
#pragma unroll
    for (int r = 0; r < 16; ++r) p1[r] = __builtin_amdgcn_exp2f(p1[r]);
    float ps = 0;
#pragma unroll
    for (int r = 0; r < 16; ++r) ps += p0[r];
#pragma unroll
    for (int r = 0; r < 16; ++r) ps += p1[r];
    { auto rr = __builtin_amdgcn_permlane32_swap(__float_as_uint(ps), __float_as_uint(ps), false, false);
      ps = __uint_as_float(rr[0]) + __uint_as_float(rr[1]); }
    l_reg = l_reg * alpha + ps;
#define PK4(P, B_, OUT) do { unsigned a0 = cvtpk(P[B_+0], P[B_+1]), a1 = cvtpk(P[B_+2], P[B_+3]);                          \
        unsigned b0 = cvtpk(P[B_+4], P[B_+5]), b1 = cvtpk(P[B_+6], P[B_+7]);                                             \
        auto r0 = __builtin_amdgcn_permlane32_swap(a0, b0, false, false); auto r1 = __builtin_amdgcn_permlane32_swap(a1, b1, false, false); \
        v4u w = {r0[0], r1[0], r0[1], r1[1]}; OUT = *reinterpret_cast<bf16x8*>(&w); } while (0)
    PK4(p0, 0, pa0); PK4(p0, 8, pa1); PK4(p1, 0, pa2); PK4(p1, 8, pa3);
#undef PK4
}
__device__ __forceinline__ int t5_bucket(int rel) {
    const int n = rel < 0 ? -rel : rel; int b;
    if (n < 8) b = n; else { const int k = (31 - __builtin_clz((unsigned)(n * n))) - 6; b = 8 + k; if (b > 15) b = 15; }
    return b + (rel > 0 ? 16 : 0);
}

struct Unit { int b, h, qb; };
struct Tensors { const bf16* PROJ; bf16* O; const float* DL; const float* relb; const u64* MASK; const float* KN; };

template <int MODE, int NOSM = 0>
__device__ __forceinline__ void attn_unit(LAS char* lds, const Tensors& T, const Unit& U) {
    const int tid = threadIdx.x, wid = __builtin_amdgcn_readfirstlane(tid >> 6), lane = tid & 63, r32 = lane & 31, hi = lane >> 5;
    const int P0 = U.qb * QB, jhi = P0 / KVBLK + 4;
    const int qlo = P0 + wid * QBLK, qi = qlo + r32;
    constexpr int CQ = MODE == 0 ? C_QA : C_QB, CK = MODE == 0 ? C_KA : C_KB, CV = MODE == 0 ? C_VA : C_VB;
    const bf16* Qp = T.PROJ + (size_t)(U.b * LSEQ + P0) * PP + CQ + U.h * HD;
    const bf16* Kb = T.PROJ + (size_t)(U.b * LSEQ) * PP + CK + U.h * HD;
    const bf16* Vb = T.PROJ + (size_t)(U.b * LSEQ) * PP + CV + U.h * HD;
    const bf16* Km = T.PROJ + (size_t)MROWS * PP + CK + U.h * HD;
    const bf16* Vm = T.PROJ + (size_t)MROWS * PP + CV + U.h * HD;
    LAS char* V_lds = lds; LAS char* K_lds = lds + 2 * SHM_V;
    LAS float* ws = (LAS float*)(lds + LDS_WS) + wid * 64; LAS float* li_l = ws; LAS float* al_l = ws + 32;
    LAS float* aux = (LAS float*)(lds + LDS_AUX);
    const int vb0 = (int)(size_t)V_lds + v_rd_base(lane);
    unsigned kofs, vofs;
    { const int row = wid * 4 + (lane >> 4), chunk = (lane & 15) ^ (row & 7); kofs = (unsigned)(row * PP + chunk * 8) * 2u;
      const int s0 = 2 * wid + (lane >> 5), kk = (s0 >> 2) * 8 + ((lane & 31) >> 2), key = (kk & ~0xC) | ((kk & 4) << 1) | ((kk & 8) >> 1), cc = (s0 & 3) * 32 + (lane & 3) * 8;
      vofs = (unsigned)(key * PP + cc) * 2u; }
#define KTILE(t) ((t) < 0 ? Km : Kb + (size_t)(t) * KVBLK * PP)
#define VTILE(t) ((t) < 0 ? Vm : Vb + (size_t)(t) * KVBLK * PP)
#define DMA_K(t, bf) do { const char* kp_ = (const char*)(KTILE(t));                                                          \
        __builtin_amdgcn_global_load_lds((const unsigned*)(kp_ + (size_t)kofs), (LAS unsigned*)(K_lds + (bf) * SHM_K + wid * 1024), 16, 0, 0);                                   \
        __builtin_amdgcn_global_load_lds((const unsigned*)(kp_ + (size_t)32 * PP * 2 + (size_t)kofs), (LAS unsigned*)(K_lds + (bf) * SHM_K + 8192 + wid * 1024), 16, 0, 0); } while (0)
#define DMA_V(t, bf) do { const char* vp_ = (const char*)(VTILE(t));                                                                                                             \
        __builtin_amdgcn_global_load_lds((const unsigned*)(vp_ + (size_t)vofs), (LAS unsigned*)(V_lds + (bf) * SHM_V + wid * 1024), 16, 0, 0);                                   \
        __builtin_amdgcn_global_load_lds((const unsigned*)(vp_ + (size_t)32 * PP * 2 + (size_t)vofs), (LAS unsigned*)(V_lds + (bf) * SHM_V + 8192 + wid * 1024), 16, 0, 0); } while (0)
#define TILE(k) (jhi - 1 - (k))
    DMA_K(TILE(0), 0); DMA_V(TILE(0), 0);
    bf16x8 qr[8];
#pragma unroll
    for (int d0 = 0; d0 < 8; ++d0) qr[d0] = *(const bf16x8*)(Qp + (size_t)(wid * QBLK + r32) * PP + d0 * 16 + hi * 8);
    float qkb = 0.f;
    if (MODE == 0) { float sq = 0.f;
#pragma unroll
        for (int d0 = 0; d0 < 8; ++d0)
#pragma unroll
            for (int e = 0; e < 8; ++e) { const float v = bf2f((unsigned short)qr[d0][e]); sq = fmaf(v, v, sq); }
        { auto rr = __builtin_amdgcn_permlane32_swap(__float_as_uint(sq), __float_as_uint(sq), false, false); sq = __uint_as_float(rr[0]) + __uint_as_float(rr[1]); }
        qkb = sqrtf(sq) * sqrtf(T.KN[U.b * NH + U.h]) * C2 * 1.001f; }
    LAS unsigned* flags = (LAS unsigned*)(lds + LDS_FLAGS);
    if (MODE == 0) {
        const float* dl = T.DL + (size_t)(U.b * NH + U.h) * DL_PITCH;
        for (int i = tid; i < (jhi + 1) * 16; i += 512) *(LAS f32x4*)(aux + 4 * i) = *(const f32x4*)(dl + 4 * i);
    } else {
        int tt = tid; asm volatile("" : "+v"(tt));
        if (tt < 256) aux[tt] = T.relb[t5_bucket(tt - 192) * NH + U.h] * LOG2E;
    }
    VM_WAIT();
    __syncthreads();
    float cfar = 0.f; if (MODE == 1) cfar = aux[0];
    float m_reg = -1e30f, l_reg = 0; f32x16 o[4] = {};
    const unsigned moff = (unsigned)(U.b * LSEQ + qi) * (MASK_PITCH * 8u);
    const float NEG = -__builtin_inff();
#define ACT(t) (KVBLK * (t) <= qlo + QBLK - 1)
#define RESC(a) do { if (__any((a) < 1.f)) { if (hi == 0) al_l[r32] = (a); asm volatile("s_waitcnt lgkmcnt(0)" ::: "memory");              \
                     for (int d_ = 0; d_ < 4; ++d_) for (int r = 0; r < 16; ++r) o[d_][r] *= al_l[crow(r, hi)]; } } while (0)
#define BIASMASK(p0, p1, t_, mw) do {                                                                                                       \
        if (MODE == 0) {                                                                                                                    \
            const LAS float* dlt = aux + ((t_) + 1) * 64 + 4 * hi;                                                                          \
            _Pragma("unroll") for (int g = 0; g < 4; ++g) { const f32x4 d0_ = *(const LAS f32x4*)(dlt + 8 * g), d1_ = *(const LAS f32x4*)(dlt + 32 + 8 * g);   \
                _Pragma("unroll") for (int j = 0; j < 4; ++j) { p0[4 * g + j] = fmaf(p0[4 * g + j], C2, d0_[j]); p1[4 * g + j] = fmaf(p1[4 * g + j], C2, d1_[j]); } }   \
            if ((t_) < 0) {                                                                                  \
                _Pragma("unroll") for (int r = 0; r < 16; ++r) { p0[r] = NEG; if (r < 8) p1[r] = NEG; }                                     \
            } else if (KVBLK * (t_) + KVBLK - 1 > qlo) {                                         \
                const int dq = qi - KVBLK * (t_) - 4 * hi;                                                                                  \
                _Pragma("unroll") for (int r = 0; r < 16; ++r) { const int c = (r & 3) + 8 * (r >> 2); if (c > dq) p0[r] = NEG; if (c + 32 > dq) p1[r] = NEG; }   \
            }                                                                                                                               \
        } else {                                                                                                                            \
            if (KVBLK * (t_) + KVBLK - 1 - qlo >= -90) {                           \
                const LAS float* tb = aux + (KVBLK * (t_) - qi + 4 * hi + 192);                                                             \
                _Pragma("unroll") for (int r = 0; r < 16; ++r) { const int c = (r & 3) + 8 * (r >> 2); p0[r] = fmaf(p0[r], C2, tb[c]); p1[r] = fmaf(p1[r], C2, tb[c + 32]); }   \
            } else {                                                                                                                        \
                _Pragma("unroll") for (int r = 0; r < 16; ++r) { p0[r] = fmaf(p0[r], C2, cfar); p1[r] = fmaf(p1[r], C2, cfar); }           \
            }                                                                                                                               \
            const unsigned mlo = (unsigned)(mw) >> (4 * hi), mhi = (unsigned)((mw) >> 32) >> (4 * hi);                                      \
            _Pragma("unroll") for (int r = 0; r < 16; ++r) { const int c = (r & 3) + 8 * (r >> 2);                                          \
                const unsigned s0_ = (unsigned)__builtin_amdgcn_sbfe((int)mlo, c, 1), s1_ = (unsigned)__builtin_amdgcn_sbfe((int)mhi, c, 1);       \
                p0[r] = __uint_as_float((__float_as_uint(p0[r]) & s0_) | (0xff800000u & ~s0_));                                             \
                p1[r] = __uint_as_float((__float_as_uint(p1[r]) & s1_) | (0xff800000u & ~s1_)); }                                           \
        } } while (0)
#define MASKWORD(t_) (MODE == 1 ? *(const u64*)((const char*)(T.MASK + ((t_) + 1)) + (size_t)moff) : (u64)0)
#define STOPFLAG(kk, t_) do { if (MODE == 0) { const float dln_ = aux[(t_) * 64 + 63];                                           \
            const bool neg_ = __all(qkb + dln_ <= m_reg - SKIP_MARGIN) != 0;                                                                \
            if (lane == 0) flags[((kk) & 1) * 8 + wid] = neg_ ? 1u : 0u; } } while (0)
#define STOPREAD(kk) do { if (MODE == 0) { const v4u f0_ = *(const LAS v4u*)(flags + ((kk) & 1) * 8), f1_ = *(const LAS v4u*)(flags + ((kk) & 1) * 8 + 4);   \
            stop = (f0_.x & f0_.y & f0_.z & f0_.w & f1_.x & f1_.y & f1_.z & f1_.w) != 0u; } } while (0)
#define FAKEPA(P0_, P1_) do { v4u w0_ = {__float_as_uint(P0_[0]), __float_as_uint(P0_[1]), __float_as_uint(P0_[2]), __float_as_uint(P0_[3])}, w1_ = {__float_as_uint(P0_[8]), __float_as_uint(P0_[9]), __float_as_uint(P0_[10]), __float_as_uint(P0_[11])}, \
        w2_ = {__float_as_uint(P1_[0]), __float_as_uint(P1_[1]), __float_as_uint(P1_[2]), __float_as_uint(P1_[3])}, w3_ = {__float_as_uint(P1_[8]), __float_as_uint(P1_[9]), __float_as_uint(P1_[10]), __float_as_uint(P1_[11])}; \
        pa0 = *reinterpret_cast<bf16x8*>(&w0_); pa1 = *reinterpret_cast<bf16x8*>(&w1_); pa2 = *reinterpret_cast<bf16x8*>(&w2_); pa3 = *reinterpret_cast<bf16x8*>(&w3_); } while (0)
#define HALF_STEP(PX0, PX1, alX, PY0, PY1, alY, kk, KB, VB) do { const int t_ = TILE(kk); const bool more_ = t_ >= 0;                          \
        if (more_) DMA_K(t_ - 1, (KB) ^ 1);                                                                                                 \
        u64 mw_ = 0; if (ACT(t_)) mw_ = MASKWORD(t_);             \
        bf16x8 pa0, pa1, pa2, pa3;                                                                                                          \
        SBAR();                                                                                                                             \
        qkt<KB>(PX0, PX1, K_lds, r32, hi, qr);                                                                                              \
        if (NOSM) { FAKEPA(PY0, PY1); } else finishSM(PY0, PY1, alY, l_reg, pa0, pa1, pa2, pa3);                                            \
        SBAR();                                                                                                                             \
        pv_tile<VB>(o, vb0, pa0, pa1, pa2, pa3);                                                                                            \
        if (NOSM) { alX = 1.f; l_reg = 1.f; } else { BIASMASK(PX0, PX1, t_, mw_); partialSM(PX0, PX1, m_reg, alX); }                        \
        SBAR();                                                                                                                             \
        if (more_) STOPFLAG(kk, t_);                                                                                                        \
        VM_WAIT(); __syncthreads();                                                                                                         \
        if (more_) STOPREAD(kk);                                                                                                            \
        if (more_) DMA_V(t_ - 1, VB);                             \
        RESC(alX); SBAR(); } while (0)
    f32x16 pA0, pA1, pB0, pB1; float alA = 1.f, alB = 1.f; bool stop = false;
    {
        DMA_K(TILE(1), 1);
        u64 mw_ = 0; if (ACT(TILE(0))) mw_ = MASKWORD(TILE(0));
        SBAR();
        qkt<0>(pA0, pA1, K_lds, r32, hi, qr); if (NOSM) { l_reg = 1.f; } else { BIASMASK(pA0, pA1, TILE(0), mw_); partialSM(pA0, pA1, m_reg, alA); }
        SBAR();
        STOPFLAG(0, TILE(0));
        VM_WAIT(); __syncthreads();
        STOPREAD(0);
        DMA_V(TILE(1), 1);
    }
    int k;
    for (k = 1; k + 1 <= jhi && !stop; k += 2) {
        HALF_STEP(pB0, pB1, alB, pA0, pA1, alA, k, 1, 0);
        HALF_STEP(pA0, pA1, alA, pB0, pB1, alB, k + 1, 0, 1);
    }
    {
        bf16x8 pa0, pa1, pa2, pa3;
        if (NOSM) { FAKEPA(pA0, pA1); } else finishSM(pA0, pA1, alA, l_reg, pa0, pa1, pa2, pa3);
        SBAR(); pv_tile<0>(o, vb0, pa0, pa1, pa2, pa3);
    }
    if (hi == 0) li_l[r32] = l_reg; asm volatile("s_waitcnt lgkmcnt(0)" ::: "memory");
    bf16* Ow = T.O + (size_t)(U.b * LSEQ + qlo) * DM + MODE * WBR + U.h * HD;
    int le = lane; asm volatile("" : "+v"(le));
    const int r32e = le & 31, hie = le >> 5; const bool odd = (r32e & 1) != 0;
    const unsigned obase = (unsigned)((4 * hie) * DM + (odd ? 32 : 0) + (r32e & ~1)) * 2u;
#pragma unroll
    for (int r = 0; r < 16; ++r) { const int orow = crow(r, hi); const float rl = __builtin_amdgcn_rcpf(li_l[orow]);
#pragma unroll
        for (int dp = 0; dp < 2; ++dp) { const float va = o[2 * dp][r] * rl, vb = o[2 * dp + 1][r] * rl;
            const float y = __shfl_xor(odd ? va : vb, 1);
            const unsigned w = odd ? cvtpk(y, vb) : cvtpk(va, y);
            *(unsigned*)((char*)Ow + (size_t)(((r & 3) + 8 * (r >> 2)) * DM + 2 * dp * 32) * 2 + (size_t)obase) = w; } }
    VM_WAIT();
    __syncthreads();
#undef RESC
#undef ACT
#undef BIASMASK
#undef MASKWORD
#undef STOPFLAG
#undef STOPREAD
#undef HALF_STEP
#undef FAKEPA
#undef TILE
#undef DMA_K
#undef DMA_V
#undef KTILE
#undef VTILE
}
}

#ifndef IDX_ASMFMA
#define IDX_ASMFMA 0
#endif
#ifndef IDX_SELBAND
#define IDX_SELBAND 0
#endif
#ifndef IDX_SELASM
#define IDX_SELASM 0
#endif
#ifndef IDX_SELDPP
#define IDX_SELDPP 0
#endif
#ifndef IDX_REP
#define IDX_REP 1
#endif
#ifndef IDX_UNROLL
#define IDX_UNROLL 2
#endif
namespace idx {
constexpr int LDS_QL = 131072, LDS_W = LDS_QL + 8192, IDX_LDS_BYTES = LDS_W + 4096;
__device__ __forceinline__ size_t sc_row(int b, int i) { const int c = i >> 6; return (size_t)b * SC_PER_BATCH + (size_t)2048 * c * (c + 3) + (size_t)(i & 63) * 64 * (c + 2); }
__device__ __forceinline__ void index_unit(char* lds, const bf16* PROJ, const bf16* KI, const float* WI, float* SC, int b, int g) {
    const int tid = threadIdx.x, wid = __builtin_amdgcn_readfirstlane(tid >> 6), lane = tid & 63, r32 = lane & 31, hi = lane >> 5;
    const int row0 = b * LSEQ + 32 * g;
#pragma unroll 4
    for (int it = 0; it < 16; ++it) { const int id = it * 512 + tid, q = id >> 8, c8 = id & 255;
        const bf16x8 v = *(const bf16x8*)(PROJ + (size_t)(row0 + q) * PP + C_QI + c8 * 8);
        *(bf16x8*)(lds + (c8 >> 1) * 1024 + q * 32 + (c8 & 1) * 16) = v; }
    float* wl = (float*)(lds + LDS_W);
    if (tid < 256) { const int q = tid >> 3, h4 = tid & 7; const f32x4 w = *(const f32x4*)(WI + (size_t)(row0 + q) * 32 + 4 * h4);
#pragma unroll
        for (int j = 0; j < 4; ++j) wl[(4 * h4 + j) * 32 + q] = 0.5f * w[j]; }
    __syncthreads();
    {
        const int q = tid >> 4, d0 = 4 * (tid & 15), off = (d0 >> 4) * 1024 + q * 32 + ((d0 >> 3) & 1) * 16 + (d0 & 7) * 2;
        float a0 = 0.f, a1 = 0.f, a2 = 0.f, a3 = 0.f;
#pragma unroll 8
        for (int h = 0; h < HIDX; ++h) { const unsigned long long v = *(const unsigned long long*)(lds + h * 4096 + off); const float w = wl[h * 32 + q];
            a0 = fmaf(w, __uint_as_float((unsigned)v << 16), a0); a1 = fmaf(w, __uint_as_float((unsigned)v & 0xffff0000u), a1);
            a2 = fmaf(w, __uint_as_float((unsigned)(v >> 32) << 16), a2); a3 = fmaf(w, __uint_as_float((unsigned)(v >> 32) & 0xffff0000u), a3); }
        const unsigned h01 = pk2(a0, a1), h23 = pk2(a2, a3);
        const float r0 = a0 - __uint_as_float(h01 << 16), r1 = a1 - __uint_as_float(h01 & 0xffff0000u), r2 = a2 - __uint_as_float(h23 << 16), r3 = a3 - __uint_as_float(h23 & 0xffff0000u);
        *(unsigned long long*)(lds + LDS_QL + off) = (unsigned long long)h01 | ((unsigned long long)h23 << 32);
        *(unsigned long long*)(lds + LDS_QL + 4096 + off) = (unsigned long long)pk2(r0, r1) | ((unsigned long long)pk2(r2, r3) << 32);
    }
    __syncthreads();
    const int c = (32 * g) >> 6, nt = c + 2;
    float* scq = SC + sc_row(b, 32 * g + r32);
#pragma unroll 1
    for (int rep_ = 0; rep_ < IDX_REP; ++rep_)
    for (int k = wid; k < nt; k += 8) {
        const int krow0 = (k == 0) ? MROWS : b * LSEQ + (k - 1) * 64;
        bf16x8 ka[2][4];
#pragma unroll
        for (int kh = 0; kh < 2; ++kh)
#pragma unroll
            for (int ks = 0; ks < 4; ++ks) ka[kh][ks] = *(const bf16x8*)(KI + (size_t)(krow0 + 32 * kh + r32) * 64 + 16 * ks + 8 * hi);
        f32x16 a0 = {}, a1 = {};
#pragma unroll
        for (int hl = 0; hl < 2; ++hl) { const char* qb = lds + LDS_QL + hl * 4096 + r32 * 32 + hi * 16;
#pragma unroll
            for (int ks = 0; ks < 4; ++ks) { const bf16x8 bq = *(const bf16x8*)(qb + ks * 1024);
                a0 = __builtin_amdgcn_mfma_f32_32x32x16_bf16(ka[0][ks], bq, a0, 0, 0, 0);
                a1 = __builtin_amdgcn_mfma_f32_32x32x16_bf16(ka[1][ks], bq, a1, 0, 0, 0); } }
#pragma unroll IDX_UNROLL
        for (int h = 0; h < HIDX; ++h) {
            const char* qb = lds + h * 4096 + r32 * 32 + hi * 16;
            f32x16 d0 = {}, d1 = {};
#pragma unroll
            for (int ks = 0; ks < 4; ++ks) { const bf16x8 bq = *(const bf16x8*)(qb + ks * 1024);
                d0 = __builtin_amdgcn_mfma_f32_32x32x16_bf16(ka[0][ks], bq, d0, 0, 0, 0);
                d1 = __builtin_amdgcn_mfma_f32_32x32x16_bf16(ka[1][ks], bq, d1, 0, 0, 0); }
            const float w = wl[h * 32 + r32];
#if IDX_ASMFMA
            asm volatile("s_nop 13" : "+v"(d0), "+v"(d1));
#pragma unroll
            for (int r = 0; r < 16; ++r) { asm volatile("v_fma_f32 %0, %1, |%2|, %0" : "+v"(a0[r]) : "v"(w), "v"(d0[r])); asm volatile("v_fma_f32 %0, %1, |%2|, %0" : "+v"(a1[r]) : "v"(w), "v"(d1[r])); }
#else
#pragma unroll
            for (int r = 0; r < 16; ++r) { a0[r] = fmaf(w, fabsf(d0[r]), a0[r]); a1[r] = fmaf(w, fabsf(d1[r]), a1[r]); }
#endif
        }
        float* dst = scq + k * 64 + 4 * hi;
#pragma unroll
        for (int g4 = 0; g4 < 4; ++g4) { *(f32x4*)(dst + 8 * g4) = (f32x4){a0[4 * g4], a0[4 * g4 + 1], a0[4 * g4 + 2], a0[4 * g4 + 3]};
                                         *(f32x4*)(dst + 32 + 8 * g4) = (f32x4){a1[4 * g4], a1[4 * g4 + 1], a1[4 * g4 + 2], a1[4 * g4 + 3]}; }
    }
    asm volatile("s_waitcnt vmcnt(0)" ::: "memory");
    __syncthreads();
}
__device__ __forceinline__ int wave_sum_dpp(int v) {
    v += __builtin_amdgcn_update_dpp(0, v, 0x111, 0xf, 0xf, false);
    v += __builtin_amdgcn_update_dpp(0, v, 0x112, 0xf, 0xf, false);
    v += __builtin_amdgcn_update_dpp(0, v, 0x114, 0xf, 0xf, false);
    v += __builtin_amdgcn_update_dpp(0, v, 0x118, 0xf, 0xf, false);
    v += __builtin_amdgcn_update_dpp(0, v, 0x142, 0xa, 0xf, false);
    v += __builtin_amdgcn_update_dpp(0, v, 0x143, 0xc, 0xf, false);
    return __builtin_amdgcn_readlane(v, 63);
}
template <int NK>
__device__ __forceinline__ void select_query(const float* row, int nt, int nvalid, u64* mout, int lane, LAS unsigned* wscr) {
    unsigned key[NK];
#pragma unroll
    for (int k = 0; k < NK; ++k) { unsigned u = 0u;
        if (k < nt) { u = __float_as_uint(row[k * 64 + lane]); u = (u & 0x80000000u) ? ~u : (u | 0x80000000u); if (k == 0 && lane < 48) u = 0u; }
        key[k] = u; }
    unsigned thr = 1u;
    if (nvalid > KTOP) { thr = 0u; int lo = 64 * NK, hi = 0; (void)lo; (void)hi;
        for (int bit = 31; bit >= 0; --bit) { const unsigned cand = thr | (1u << bit);
#if IDX_SELDPP
            int c0 = 0, c1 = 0;
#pragma unroll
            for (int k = 0; k < NK; ++k) { if (k & 1) c1 += (key[k] >= cand) ? 1 : 0; else c0 += (key[k] >= cand) ? 1 : 0; }
            const int cnt = wave_sum_dpp(c0 + c1);
#elif IDX_SELASM
            int cnt = 0;
#pragma unroll
            for (int k0 = 0; k0 + 8 <= NK; k0 += 8) { u64 m0, m1, m2, m3, m4, m5, m6, m7;
                asm("v_cmp_ge_u32_e64 %0, %8, %16\n\tv_cmp_ge_u32_e64 %1, %9, %16\n\tv_cmp_ge_u32_e64 %2, %10, %16\n\tv_cmp_ge_u32_e64 %3, %11, %16\n\t"
                    "v_cmp_ge_u32_e64 %4, %12, %16\n\tv_cmp_ge_u32_e64 %5, %13, %16\n\tv_cmp_ge_u32_e64 %6, %14, %16\n\tv_cmp_ge_u32_e64 %7, %15, %16"
                    : "=&s"(m0), "=&s"(m1), "=&s"(m2), "=&s"(m3), "=&s"(m4), "=&s"(m5), "=&s"(m6), "=&s"(m7)
                    : "v"(key[k0]), "v"(key[k0 + 1]), "v"(key[k0 + 2]), "v"(key[k0 + 3]), "v"(key[k0 + 4]), "v"(key[k0 + 5]), "v"(key[k0 + 6]), "v"(key[k0 + 7]), "v"(cand));
                cnt += (__builtin_popcountll(m0) + __builtin_popcountll(m1)) + (__builtin_popcountll(m2) + __builtin_popcountll(m3)) + (__builtin_popcountll(m4) + __builtin_popcountll(m5)) + (__builtin_popcountll(m6) + __builtin_popcountll(m7)); }
#pragma unroll
            for (int k = NK & ~7; k < NK; ++k) cnt += __builtin_popcountll(__ballot(key[k] >= cand));
#else
            int cnt = 0;
#pragma unroll
            for (int k = 0; k < NK; ++k) cnt += __builtin_popcountll(__ballot(key[k] >= cand));
#endif
#if IDX_SELBAND
            if (cnt >= KTOP) { thr = cand; lo = cnt; } else hi = cnt;
            if (cnt == KTOP) break;
            if (thr != 0u && lo - hi <= 64 && bit > 0) {
                const unsigned span = 1u << bit; int base = 0;
#pragma unroll
                for (int k = 0; k < NK; ++k) { const bool inb = (key[k] - thr) < span; const u64 m = __ballot(inb);
                    const int pos = base + (int)__builtin_amdgcn_mbcnt_hi((unsigned)(m >> 32), __builtin_amdgcn_mbcnt_lo((unsigned)m, 0u));
                    if (inb) wscr[pos] = key[k];
                    base += __builtin_popcountll(m); }
                asm volatile("s_waitcnt lgkmcnt(0)" ::: "memory");
                const unsigned bk = lane < base ? wscr[lane] : 0u;
                for (int b2 = bit - 1; b2 >= 0; --b2) { const unsigned c2 = thr | (1u << b2); const int n2 = hi + __builtin_popcountll(__ballot(bk >= c2));
                    if (n2 >= KTOP) thr = c2;
                    if (n2 == KTOP) break; }
                break; } } }
#else
            if (cnt >= KTOP) thr = cand;
            if (cnt == KTOP) break; } }
#endif
    u64 mine = 0, w64 = 0, w65 = 0;
#pragma unroll
    for (int k = 0; k < NK; ++k) { const u64 bm = __ballot(key[k] >= thr); if (k < 64) { if (lane == k) mine = bm; } else if (k == 64) w64 = bm; else w65 = bm; }
    if (lane < nt) mout[lane] = mine;
    if (NK > 64 && nt > 64 && lane == 0) mout[64] = w64;
    (void)w65;
}
__device__ __forceinline__ void select_dispatch(const float* SC, u64* MASK, int b, int i, int lane, LAS unsigned* wscr) {
    const int c = i >> 6, nt = c + 2, nvalid = NMETA + 64 * (c + 1);
    const float* row = SC + sc_row(b, i); u64* mout = MASK + (size_t)(b * LSEQ + i) * MASK_PITCH;
    if (nt <= 17) select_query<17>(row, nt, nvalid, mout, lane, wscr);
    else if (nt <= 33) select_query<33>(row, nt, nvalid, mout, lane, wscr);
    else if (nt <= 49) select_query<49>(row, nt, nvalid, mout, lane, wscr);
    else select_query<65>(row, nt, nvalid, mout, lane, wscr);
}
__device__ __forceinline__ void knorm_unit(const bf16* PROJ, unsigned* KN2, int b, int h, int part) {
    const int tid = threadIdx.x, lane = tid & 63, wid = tid >> 6;
    constexpr int NKEY = LSEQ + NMETA, PER = NKEY / 4;
    float kmax = 0.f;
    constexpr int NIT = (PER + 31) / 32;
#pragma unroll 11
    for (int i = 0; i < NIT; ++i) { const int kq = i * 32 + wid * 4 + (lane >> 4); const bool ok = kq < PER; const int key = part * PER + (ok ? kq : 0);
        const int row = key < LSEQ ? b * LSEQ + key : METAROW + (key - LSEQ);
        const bf16x8 v = *(const bf16x8*)(PROJ + (size_t)row * PP + C_KA + h * HD + (lane & 15) * 8);
        float sq = 0.f;
#pragma unroll
        for (int e = 0; e < 8; ++e) { const float f = bf2f((unsigned short)v[e]); sq = fmaf(f, f, sq); }
        sq += __shfl_xor(sq, 1); sq += __shfl_xor(sq, 2); sq += __shfl_xor(sq, 4); sq += __shfl_xor(sq, 8);
        kmax = fmaxf(kmax, ok ? sq : 0.f); }
    kmax = fmaxf(kmax, __shfl_xor(kmax, 16)); kmax = fmaxf(kmax, __shfl_xor(kmax, 32));
    if (lane == 0) __hip_atomic_fetch_max(KN2 + b * NH + h, __float_as_uint(kmax), __ATOMIC_RELAXED, __HIP_MEMORY_SCOPE_AGENT);
}
__device__ __forceinline__ void scan_unit(char* lds, const float* LF, float* DL, int b, int h) {
    const int tid = threadIdx.x, lane = tid & 63, wid = tid >> 6;
    float* red = (float*)lds;
    float v[8], s = 0.f;
#pragma unroll
    for (int k = 0; k < 8; ++k) { v[k] = LF[(size_t)(b * LSEQ + 8 * tid + k) * 16 + h]; s += v[k]; v[k] = s; }
    float inc = s;
#pragma unroll
    for (int o = 1; o < 64; o <<= 1) { const float n = __shfl_up(inc, o); if (lane >= o) inc += n; }
    if (lane == 63) red[wid] = inc;
    float mt = 0.f, mcum = 0.f;
    for (int sidx = 0; sidx < NMETA; ++sidx) { const float x = LF[(size_t)(METAROW + sidx) * 16 + h]; mt += x; if (sidx <= tid) mcum = mt; }
    __syncthreads();
    float base = mt;
    for (int w = 0; w < wid; ++w) base += red[w];
    base += inc - s;
    float* dl = DL + (size_t)(b * NH + h) * DL_PITCH;
#pragma unroll
    for (int k = 0; k < 8; ++k) dl[64 + 8 * tid + k] = -LOG2E * (base + v[k]);
    if (tid < 48) dl[tid] = 0.f; else if (tid < 64) { }
    if (tid < NMETA) dl[48 + tid] = -LOG2E * mcum;
    __syncthreads();
}
}

constexpr int NWAVES = 8;
#define MK_N_LAUNCHES 1
constexpr int N_PHASES = 12;
constexpr int N_LAUNCHES = MK_N_LAUNCHES;
static_assert(N_LAUNCHES == 1 || N_LAUNCHES == N_PHASES, "MK_N_LAUNCHES is 1 or N_PHASES");

constexpr size_t MiB = 1u << 20;
constexpr size_t WS_CTL = 0, CTL_ZERO_BYTES = 1 * MiB;
constexpr size_t WS_WIN = 1 * MiB;
constexpr size_t WS_WBF = 179 * MiB;
constexpr size_t WS_WBD = 195 * MiB;
constexpr size_t WS_WO  = 211 * MiB;
constexpr size_t WS_U   = 244 * MiB;
constexpr size_t WS_SC  = WS_U;
constexpr size_t WS_LF  = 380 * MiB;
constexpr size_t WS_KI  = 382 * MiB;
constexpr size_t WS_WI  = 385 * MiB;
constexpr size_t WS_DL  = 388 * MiB;
constexpr size_t WS_MASK = 390 * MiB;
constexpr size_t WS_O   = 400 * MiB;
constexpr size_t WS_PROJ = 528 * MiB;
constexpr size_t WS_G   = 983 * MiB;
constexpr size_t WS_MIX = WS_PROJ;
constexpr size_t WS_ACT = WS_PROJ;
constexpr size_t WS_WUP = WS_WIN;
constexpr size_t WS_WDN = 1240 * MiB;
constexpr size_t WS_U8  = 1296 * MiB;
constexpr size_t WS_W8  = WS_O;
constexpr size_t WS_END = 1368 * MiB;
static_assert(WS_WIN + (size_t)NIN * DM * 2 <= WS_WBF && WS_U + (size_t)NB * SC_PER_BATCH * 4 <= WS_LF && WS_U + (size_t)MPAD * DM * 2 <= WS_LF, "ws map 1");
static_assert(WS_MASK + (size_t)MROWS * MASK_PITCH * 8 <= WS_O && WS_PROJ + (size_t)MPAD * PP * 2 <= WS_G && WS_ACT + (size_t)MROWS * DFF * 2 <= WS_WDN && WS_WUP + (size_t)DFF * DM * 2 <= WS_WBF && WS_G + (size_t)MROWS * 8192 * 2 <= WS_WDN && WS_WDN + (size_t)DFF * DM * 2 <= WS_END, "ws map 2");
constexpr int CW_TMO = 0, CW_CODE = 1, CW_BAR = 4096;

#ifndef P9_ALIGN
#define P9_ALIGN true
#endif
#ifndef P9_SP2
#define P9_SP2 true
#endif
#ifndef P9_EPIREP
#define P9_EPIREP 1
#endif
#ifndef PROBE_GEMM_L2
#define PROBE_GEMM_L2 0
#endif
#ifndef PROBE_ATT
#define PROBE_ATT 0
#endif
#ifndef PROBE_GEMM_MODE
#define PROBE_GEMM_MODE 0
#endif
#ifndef P1F_ALIGN
#define P1F_ALIGN true
#endif
#ifndef IDX_SELREP
#define IDX_SELREP 1
#endif
#ifndef DSA_BR_FP8
#define DSA_BR_FP8 1
#endif
#ifndef H1_BF16
#define H1_BF16 1
#endif
#ifndef P9_DELAY
#define P9_DELAY 0
#endif
#ifndef P10_PMR
#define P10_PMR 8
#endif
constexpr int RING_OFF = 0;
constexpr int LDSCTL_OFF = 147456, MISC_OFF = LDSCTL_OFF + 320;
constexpr int LDS_BYTES = 151552;
static_assert(idx::IDX_LDS_BYTES + NWAVES * 256 <= LDSCTL_OFF && att::ATT_LDS_BYTES <= LDSCTL_OFF && pg8::STAGE_BYTES <= LDSCTL_OFF && MISC_OFF + 128 <= LDS_BYTES, "LDS map");

#define XB_TMO      128
#define XB_XCNT(j)  (256  + 64 * (j))
#define XB_XSUB(j)  (1280 + 64 * (j))
#define XB_XGEN(j)  (2304 + 64 * (j))
#define XB_TOP      3328
#define XB_TOPGEN   3392
#define XCD_BAR_WORDS 3456
#define XB_SPIN_CAP (1u << 18)

__device__ __forceinline__ unsigned xb_ld(unsigned* p)              { return __hip_atomic_load(p, __ATOMIC_RELAXED, __HIP_MEMORY_SCOPE_AGENT); }
__device__ __forceinline__ unsigned xb_add(unsigned* p, unsigned v) { return __hip_atomic_fetch_add(p, v, __ATOMIC_RELAXED, __HIP_MEMORY_SCOPE_AGENT); }
__device__ __forceinline__ unsigned xb_xcc_id() { return (unsigned)__builtin_amdgcn_s_getreg((3 << 11) | 20) & 0xFu; }
#define XB_SPIN(cond, bar) do { unsigned _sp = 0; while (cond) { __builtin_amdgcn_s_sleep(1); \
    if ((++_sp & 255u) == 0u) { if (xb_ld(&(bar)[XB_TMO])) break; if (_sp > XB_SPIN_CAP) { atomicAdd(&(bar)[XB_TMO], 1u); break; } } } } while (0)

struct XcdBarrier {
    unsigned* bar; unsigned x;
    volatile LAS unsigned* st;
};

__device__ __forceinline__ XcdBarrier xcd_barrier_post(unsigned* bar, volatile LAS unsigned* st) {
    XcdBarrier b; b.bar = bar; b.x = xb_xcc_id(); b.st = st;
    if (threadIdx.x == 0) (void)xb_add(&bar[XB_XCNT(b.x)], 1u);
    return b;
}
__device__ __forceinline__ void xcd_barrier_complete(unsigned* bar, unsigned x, unsigned& nloc, unsigned& nx) {
    const unsigned G = gridDim.x * gridDim.y * gridDim.z;
    unsigned sum, cnt, mine, sp = 0u;
    for (;;) {
        sum = 0u; cnt = 0u; mine = 0u;
#pragma unroll
        for (unsigned j = 0; j < 16; ++j) { const unsigned c = xb_ld(&bar[XB_XCNT(j)]); sum += c; cnt += (c > 0u) ? 1u : 0u; mine = (j == x) ? c : mine; }
        if (sum == G) break;
        __builtin_amdgcn_s_sleep(1);
        if ((++sp & 255u) == 0u) { if (xb_ld(&bar[XB_TMO])) break; if (sp > XB_SPIN_CAP) { atomicAdd(&bar[XB_TMO], 1u); break; } }
    }
    nloc = mine > 0u ? mine : 1u; nx = cnt > 0u ? cnt : 1u;
}

__device__ __forceinline__ void xcd_barrier(const XcdBarrier& b) {
    asm volatile("s_waitcnt vmcnt(0)" ::: "memory");
    __syncthreads();
    if (threadIdx.x == 0) {
        unsigned* bar = b.bar;
        __builtin_amdgcn_s_waitcnt(0);
        unsigned nloc = b.st[0], nx = b.st[1];
        if (nloc == 0u) { xcd_barrier_complete(bar, b.x, nloc, nx); b.st[0] = nloc; b.st[1] = nx; }
        const unsigned old = xb_add(&bar[XB_XSUB(b.x)], 1u);
        const unsigned gen = old / nloc;
        if (old + 1u == (gen + 1u) * nloc) {
            __builtin_amdgcn_fence(__ATOMIC_RELEASE, "agent");
            asm volatile("s_waitcnt vmcnt(0)" ::: "memory");
            const unsigned og = xb_add(&bar[XB_TOP], 1u);
            const unsigned tg = og / nx;
            if (og + 1u == (tg + 1u) * nx) xb_add(&bar[XB_TOPGEN], 1u);
            else XB_SPIN(xb_ld(&bar[XB_TOPGEN]) == tg, bar);
            __builtin_amdgcn_fence(__ATOMIC_ACQUIRE, "agent");
            xb_add(&bar[XB_XGEN(b.x)], 1u);
            asm volatile("s_waitcnt vmcnt(0)" ::: "memory");
        } else {
            XB_SPIN(xb_ld(&bar[XB_XGEN(b.x)]) == gen, bar);
            __builtin_amdgcn_fence(__ATOMIC_ACQUIRE, "agent");
            asm volatile("s_waitcnt vmcnt(0)" ::: "memory");
        }
    }
    __syncthreads();
}


__device__ __forceinline__ float wave_sum(float v) {
#pragma unroll
    for (int o = 1; o < 64; o <<= 1) v += __shfl_xor(v, o);
    return v;
}
__device__ __forceinline__ int win_src_col(int n) {
    if (n < 6144) return n;
    if (n < 14336) return n + 16;
    if (n < 22528) return n + 112;
    if (n < 22544) return 6144 + (n - 22528);
    if (n < 22608) return 14352 + (n - 22544);
    if (n < 22640) return 14416 + (n - 22608);
    return -1;
}
template <int MAP>
__device__ __forceinline__ void transpose_item(const float* W, int K, int Nsrc, int N, bf16* WT, LAS float* scr, int item, int lane, unsigned char* W8 = nullptr, const float* ksc = nullptr) {
    const int nblk = N / 32, kb = item / nblk, nb = item % nblk, k0 = 64 * kb, n0 = 32 * nb;
    const int nd = n0 + (lane & 31), ns = MAP == 1 ? win_src_col(nd) : nd;
    float tv[32];
    const float* wp = W + (size_t)(k0 + (lane >> 5)) * Nsrc + (ns >= 0 ? ns : 0);
#pragma unroll
    for (int i = 0; i < 32; ++i) tv[i] = wp[(size_t)(2 * i) * Nsrc];
#pragma unroll
    for (int i = 0; i < 32; ++i) scr[(2 * i + (lane >> 5)) * 33 + (lane & 31)] = ns >= 0 ? (ksc ? tv[i] * ksc[k0 + 2 * i + (lane >> 5)] : tv[i]) : 0.f;
    LDS_WAIT(); asm volatile("" ::: "memory");
    const int c = lane & 7;
    const bool isq = n0 < 2048 || (n0 >= 6144 && n0 < 8192), isk = (n0 >= 2048 && n0 < 4096) || (n0 >= 8192 && n0 < 10240), isv = (n0 >= 4096 && n0 < 6144) || (n0 >= 10240 && n0 < 12288);
    const bool isg = n0 >= 14336 && n0 < 22528;
    const bool f8 = MAP == 2 || (MAP == 1 && (isg || isv || (FP8_QK && (isq || isk)))), b16 = MAP != 2 && (!f8 || isk || isv);
    if (f8) {
#pragma unroll
        for (int j = 0; j < 4; ++j) { const int n = (lane >> 3) + 8 * j; const LAS float* s = scr + (8 * c) * 33 + n;
            int lo = 0, hi = 0;
            lo = __builtin_amdgcn_cvt_pk_fp8_f32(64.f * s[0 * 33], 64.f * s[1 * 33], lo, false); lo = __builtin_amdgcn_cvt_pk_fp8_f32(64.f * s[2 * 33], 64.f * s[3 * 33], lo, true);
            hi = __builtin_amdgcn_cvt_pk_fp8_f32(64.f * s[4 * 33], 64.f * s[5 * 33], hi, false); hi = __builtin_amdgcn_cvt_pk_fp8_f32(64.f * s[6 * 33], 64.f * s[7 * 33], hi, true);
            *(GAS u64*)(W8 + (size_t)(n0 + n) * K + k0 + 8 * c) = (u64)(unsigned)lo | ((u64)(unsigned)hi << 32); }
    }
    if (b16) {
#pragma unroll
    for (int j = 0; j < 4; ++j) { const int n = (lane >> 3) + 8 * j; const LAS float* s = scr + (8 * c) * 33 + n;
        v4u o; o.x = pk2(s[0 * 33], s[1 * 33]); o.y = pk2(s[2 * 33], s[3 * 33]); o.z = pk2(s[4 * 33], s[5 * 33]); o.w = pk2(s[6 * 33], s[7 * 33]);
        *(GAS v4u*)(WT + (size_t)(n0 + n) * K + k0 + 8 * c) = o; }
    }
    LDS_WAIT(); asm volatile("" ::: "memory");
}
template <bool F8 = false>
__device__ __forceinline__ void rms_row_to_bf16(const float* xrow, const float* g, bf16* orow, int lane, unsigned char* o8row = nullptr) {
    const GAS f32x4* xr = (const GAS f32x4*)xrow + lane; const GAS f32x4* gr = (const GAS f32x4*)g + lane;
    f32x4 v[16]; float s = 0.f;
#pragma unroll
    for (int j = 0; j < 16; ++j) { v[j] = xr[64 * j]; s += (v[j].x * v[j].x + v[j].y * v[j].y) + (v[j].z * v[j].z + v[j].w * v[j].w); }
    const float r = 1.0f / sqrtf(wave_sum(s) * (1.f / DM) + RMS_EPS);
    GAS u64* o8 = (GAS u64*)orow + lane;
#pragma unroll
    for (int j = 0; j < 16; ++j) { const f32x4 gg = gr[64 * j]; const float y0 = v[j].x * r * gg.x, y1 = v[j].y * r * gg.y, y2 = v[j].z * r * gg.z, y3 = v[j].w * r * gg.w;
        o8[64 * j] = (u64)pk2(y0, y1) | ((u64)pk2(y2, y3) << 32);
        if (F8) { int w = 0; w = __builtin_amdgcn_cvt_pk_fp8_f32(y0, y1, w, false); w = __builtin_amdgcn_cvt_pk_fp8_f32(y2, y3, w, true); ((GAS int*)o8row)[64 * j + lane] = w; } }
}
__device__ __forceinline__ void rms_row_inplace(float* xrow, const float* g, int lane) {
    GAS f32x4* xr = (GAS f32x4*)xrow + lane; const GAS f32x4* gr = (const GAS f32x4*)g + lane;
    f32x4 v[16]; float s = 0.f;
#pragma unroll
    for (int j = 0; j < 16; ++j) { v[j] = xr[64 * j]; s += (v[j].x * v[j].x + v[j].y * v[j].y) + (v[j].z * v[j].z + v[j].w * v[j].w); }
    const float r = 1.0f / sqrtf(wave_sum(s) * (1.f / DM) + RMS_EPS);
#pragma unroll
    for (int j = 0; j < 16; ++j) { const f32x4 gg = gr[64 * j]; xr[64 * j] = (f32x4){v[j].x * r * gg.x, v[j].y * r * gg.y, v[j].z * r * gg.z, v[j].w * r * gg.w}; }
}

struct Args { const float* in[13]; float* out; unsigned char* ws; int ph_lo, ph_hi; };
static_assert(sizeof(Args) == 13 * 8 + 8 + 8 + 8, "Args has no padding");
__global__ void __launch_bounds__(NWAVES * 64, 2) fwd(Args args) {
    extern __shared__ __attribute__((aligned(16))) unsigned char lds[];
    LAS unsigned char* ldsl = (LAS unsigned char*)lds;
    volatile LAS unsigned* MISC = (volatile LAS unsigned*)(ldsl + MISC_OFF);
    const int tid = threadIdx.x, lane = tid & 63, wave = __builtin_amdgcn_readfirstlane(tid >> 6);
    const int G = gridDim.x, bx = blockIdx.x;
    const int gw = bx * NWAVES + wave, NGW = G * NWAVES;
    unsigned char* ws = args.ws;
    gu32* ctl = (gu32*)(ws + WS_CTL);
    const float* x = args.in[0]; const float* meta = args.in[1]; const float* g_attn = args.in[2]; const float* w_in = args.in[3]; const float* fbias = args.in[4];
    const float* relb = args.in[5]; const float* w_bf = args.in[6]; const float* w_bd = args.in[7]; const float* w_o = args.in[8]; const float* g_mlp = args.in[9];
    const float* w_up = args.in[10]; const float* w_dn = args.in[11]; const float* g_fin = args.in[12]; float* out = args.out;
    bf16* WIN = (bf16*)(ws + WS_WIN); bf16* WBF = (bf16*)(ws + WS_WBF); bf16* WBD = (bf16*)(ws + WS_WBD); bf16* WO = (bf16*)(ws + WS_WO);
    bf16* WUP = (bf16*)(ws + WS_WUP); bf16* WDN = (bf16*)(ws + WS_WDN);
    bf16* U = (bf16*)(ws + WS_U); float* SC = (float*)(ws + WS_SC); float* LF = (float*)(ws + WS_LF); bf16* KI = (bf16*)(ws + WS_KI); float* WI = (float*)(ws + WS_WI);
    float* PS = (float*)(ws + WS_LF); float* RS2 = (float*)(ws + WS_LF + 6 * MiB);     float* DL = (float*)(ws + WS_DL); float* KN = (float*)(ws + WS_DL + 3 * MiB / 2); u64* MASK = (u64*)(ws + WS_MASK); bf16* OB = (bf16*)(ws + WS_O); bf16* PROJ = (bf16*)(ws + WS_PROJ); bf16* GB = (bf16*)(ws + WS_G);
    bf16* MIX = (bf16*)(ws + WS_MIX); bf16* ACT = (bf16*)(ws + WS_ACT); unsigned char* U8 = ws + WS_U8; unsigned char* W8 = ws + WS_W8; unsigned char* O8D = ws + WS_WIN + 129 * MiB;     unsigned char* MIX8 = ws + WS_MIX + 128 * MiB;
    for (int u = tid; u < (LDS_BYTES - LDSCTL_OFF) / 4; u += NWAVES * 64) ((LAS unsigned*)(ldsl + LDSCTL_OFF))[u] = 0u;
    __syncthreads();
    XcdBarrier bar; bar.bar = (unsigned*)(ctl + CW_BAR); bar.x = 0; bar.st = nullptr;
    if (N_LAUNCHES == 1) bar = xcd_barrier_post((unsigned*)(ctl + CW_BAR), MISC + 8);
    const int lo = args.ph_lo, hi = args.ph_hi;
#ifndef PHASE_MASK
#define PHASE_MASK 0xfff
#endif
#define IN(k) (((PHASE_MASK >> (k)) & 1) && lo <= (k) && (k) < hi)
#define SEAM(k) do { if (IN(k) && IN((k) + 1)) xcd_barrier(bar); } while (0)

    if (IN(0)) {
        LAS float* scr = (LAS float*)(ldsl + RING_OFF + wave * 16384);
        constexpr int I_IN = (DM / 64) * (NIN / 32);
        for (int it = gw; it < I_IN; it += NGW) transpose_item<1>(w_in, DM, DIN, NIN, WIN, scr, it, lane, W8);
        if (bx == 0 && tid < NB * NH) KN[tid] = 0.f;
        for (int m = gw; m < MPAD; m += NGW) {
            if (m < MROWS) rms_row_to_bf16<true>(x + (size_t)m * DM, g_attn, U + (size_t)m * DM, lane, U8 + (size_t)m * DM);
            else if (m >= METAROW && m < METAROW + NMETA) rms_row_to_bf16(meta + (size_t)(m - METAROW) * DM, g_attn, U + (size_t)m * DM, lane);
            else { GAS v4u* o = (GAS v4u*)(U + (size_t)m * DM) + lane;
#pragma unroll
                for (int j = 0; j < 8; ++j) o[64 * j] = (v4u){0u, 0u, 0u, 0u}; }
        }
    }
    SEAM(0);
    if (IN(1)) {
        {
            constexpr int P1X = (pg8::proj_bf16_tiles() * 64 + 33) % 256;
            constexpr int I_BR = (WBR / 64) * (DM / 32), I_O = (DM / 64) * (DM / 32);
            const int x0 = G > P1X ? P1X : 0;
            if (bx >= x0) {
                LAS float* scr = (LAS float*)(ldsl + RING_OFF + wave * 16384);
                for (int it = (bx - x0) * NWAVES + wave; it < 2 * I_BR + I_O; it += (G - x0) * NWAVES) {
                    int r = it;
                    if (r < I_BR) { transpose_item<0>(w_bf, WBR, DM, DM, WBF, scr, r, lane); continue; } r -= I_BR;
                    if (r < I_BR) { transpose_item<DSA_BR_FP8 ? 2 : 0>(w_bd, WBR, DM, DM, WBD, scr, r, lane, (unsigned char*)WBD); continue; } r -= I_BR;
                    transpose_item<W_OUT_FP8 ? 2 : 0>(w_o, DM, DM, DM, WO, scr, r, lane, (unsigned char*)WO);
                }
                __syncthreads();
            }
        }
        { pg8::Gemm g{U, WIN, DM, DM, DM}; pg8::ProjOrder S; S.init(MROWS, pg8::proj_bf16_tiles() * 256, G, bx);
          pg8::EpiProj E{PROJ, LF, KI, WI, fbias};
          pg8::gemm_phase<pg8::EpiProj, pg8::ProjOrder, true, true>(ldsl + RING_OFF, g, S, E); }
        { pg8::Gemm g{(const bf16*)U8, (const bf16*)W8, DM / 2, DM / 2, DM / 2};
          pg8::Proj8Order S; S.init(MROWS, pg8::proj_fp8_tiles() * 256, G, bx);
          pg8::EpiProj8 E{PROJ, GB};
          pg8::gemm_phase<pg8::EpiProj8, pg8::Proj8Order, P1F_ALIGN, true, 1, 0, true>(ldsl + RING_OFF, g, S, E); }
    }
    SEAM(1);
    if (IN(2)) {
        for (int u = bx; u < 4 * NB * NH; u += G) idx::knorm_unit(PROJ, (unsigned*)KN, (u >> 2) / NH, (u >> 2) % NH, u & 3);
        for (int u = bx; u < NB * NH; u += G) idx::scan_unit((char*)lds, LF, DL, u / NH, u % NH);
        for (int u = bx; u < 256; u += G) { const int b = u >> 6, g0 = u & 63;
            for (int k = 0; k < 2; ++k) { const int g = k == 0 ? 127 - g0 : g0;
                idx::index_unit((char*)lds, PROJ, KI, WI, SC, b, g);
                for (int j = 0; j < 4 * IDX_SELREP; ++j) idx::select_dispatch(SC, MASK, b, 32 * g + 4 * wave + (j & 3), lane, (LAS unsigned*)(ldsl + idx::IDX_LDS_BYTES + wave * 256)); } }
    }
    SEAM(2);
    if (IN(3)) {
        const att::Tensors T{PROJ, OB, DL, relb, MASK, KN};
        const int vcu = (G % 8 == 0) ? (bx % 8) * (G / 8) + bx / 8 : bx;
        for (int u = vcu; u < 256; u += G) { const int bh = u >> 2, q = u & 3;
            for (int k = 0; k < 4; ++k) { const int qb = k == 0 ? 15 - q : (k == 1 ? 11 - q : (k == 2 ? 4 + q : q));
                att::attn_unit<0>((LAS char*)ldsl, T, att::Unit{bh >> 4, bh & 15, qb}); } }
        for (int u = vcu; u < 256; u += G) { const int bh = u >> 2, q = u & 3;
            for (int k = 0; k < 4; ++k) { const int qb = k == 0 ? 15 - q : (k == 1 ? 11 - q : (k == 2 ? 4 + q : q));
                att::attn_unit<1>((LAS char*)ldsl, T, att::Unit{bh >> 4, bh & 15, qb});
#if DSA_BR_FP8
                {
                    const int row = (bh >> 4) * LSEQ + 256 * qb + (tid >> 1), c0 = (bh & 15) * HD + (tid & 1) * 64;
                    const GAS v4u* src = (const GAS v4u*)(OB + (size_t)row * DM + WBR + c0); GAS v4u* dst = (GAS v4u*)(O8D + (size_t)row * WBR + c0);
                    v4u in[8];
#pragma unroll
                    for (int j = 0; j < 8; ++j) in[j] = src[j];
#pragma unroll
                    for (int j = 0; j < 4; ++j) { v4u o;
#pragma unroll
                        for (int e = 0; e < 4; ++e) { const unsigned w0 = in[2 * j + (e >> 1)][2 * (e & 1)], w1 = in[2 * j + (e >> 1)][2 * (e & 1) + 1]; int pk = 0;
                            pk = __builtin_amdgcn_cvt_pk_fp8_f32(16.f * __uint_as_float(w0 << 16), 16.f * __uint_as_float(w0 & 0xffff0000u), pk, false);
                            pk = __builtin_amdgcn_cvt_pk_fp8_f32(16.f * __uint_as_float(w1 << 16), 16.f * __uint_as_float(w1 & 0xffff0000u), pk, true);
                            o[e] = (unsigned)pk; }
                        dst[j] = o; } }
#endif
            } }
    }
    SEAM(3);
    constexpr int I_UP = (DM / 64) * (DFF / 32), I_DN = (DFF / 64) * (DM / 32);
    const int cgrp = (bx >> 3) % 3, cgn = (((G >> 3) - cgrp + 2) / 3) * 8;
    const bool cstag = (G & 7) == 0 && (G >> 3) >= 3;
#define COPY_ITEMS(first, step, lo_, hi_) do { LAS float* scr = (LAS float*)(ldsl + RING_OFF + wave * 16384);                               \
        for (int it = (lo_) + (first); it < (hi_); it += (step)) { if (it < I_UP) transpose_item<0>(w_up, DM, DFF, DFF, WUP, scr, it, lane, nullptr, H1_BF16 ? g_mlp : nullptr); else transpose_item<0>(w_dn, DFF, DM, DM, WDN, scr, it - I_UP, lane); } \
        __syncthreads(); } while (0)
#define COPY_GROUP(k) do { if (cstag && cgrp == (k)) { const int lo_ = (int)(((long)(I_UP + I_DN) * (k)) / 3), hi_ = (int)(((long)(I_UP + I_DN) * ((k) + 1)) / 3);            \
        COPY_ITEMS((((bx >> 3) / 3) * 8 + (bx & 7)) * NWAVES + wave, cgn * NWAVES, lo_, hi_); } } while (0)
    if (IN(5)) {
        if (!cstag) COPY_ITEMS(gw, NGW, 0, I_UP + I_DN);
        COPY_GROUP(0);
        pg8::Gemm g{OB, WBF, DM, WBR, WBR}; pg8::StaticOrder S; S.init(MROWS, DM, G, bx);
        pg8::EpiGate<true> E{MIX, GB, 0, nullptr, 1.f};
        pg8::gemm_phase<pg8::EpiGate<true>, pg8::StaticOrder, true, true>(ldsl + RING_OFF, g, S, E);
    }
    if (IN(5) && IN(6)) { VM_WAIT(); __syncthreads(); }
    if (IN(6)) {
        COPY_GROUP(1);
        pg8::StaticOrder S; S.init(MROWS, DM, G, bx);
#if DSA_BR_FP8
        { pg8::Gemm g{(const bf16*)O8D, (const bf16*)WBD, WBR / 2, WBR / 2, WBR / 2};
          pg8::EpiGate<false> E{MIX, GB, DM, MIX8, 1.f / 1024.f};
          pg8::gemm_phase<pg8::EpiGate<false>, pg8::StaticOrder, true, true, 1, 0, true>(ldsl + RING_OFF, g, S, E); }
#else
        { pg8::Gemm g{OB + WBR, WBD, DM, WBR, WBR};
          pg8::EpiGate<false> E{MIX, GB, DM, MIX8, 1.f};
          pg8::gemm_phase<pg8::EpiGate<false>, pg8::StaticOrder, true, true>(ldsl + RING_OFF, g, S, E); }
#endif
        COPY_GROUP(2);
    }
#undef COPY_GROUP
#undef COPY_ITEMS
    SEAM(6);
    if (IN(7)) {
        pg8::StaticOrder S; S.init(MROWS, DM, G, bx);
        if constexpr (W_OUT_FP8) { pg8::Gemm g{(const bf16*)MIX8, (const bf16*)WO, DM / 2, DM / 2, DM / 2};
            pg8::EpiResidNorm E{x, out, U, g_mlp, PS, DM, 1.f / 1024.f};
            pg8::gemm_phase<pg8::EpiResidNorm, pg8::StaticOrder, true, true, 1, 0, true>(ldsl + RING_OFF, g, S, E); }
        else { pg8::Gemm g{MIX, WO, DM, DM, DM};
            pg8::EpiResidNorm E{x, out, U, g_mlp, PS, DM, 1.f};
            pg8::gemm_phase<pg8::EpiResidNorm, pg8::StaticOrder, true, true>(ldsl + RING_OFF, g, S, E); }
    }
    do { if (IN(7) && IN(9)) xcd_barrier(bar); } while (0);
    if (IN(9)) {
        pg8::Gemm g{U, WUP, DM, DM, DM}; pg8::UpOrder S; S.init(MROWS, DFF, G, bx);
        {
            pg8::Unit uu; int lastpm = -1;
            for (int i = 0; S.next(i, uu); ++i) if (uu.pm != lastpm) { lastpm = uu.pm;
                if (tid < 256) { const int m = uu.pm * 256 + tid; const f32x4* ps = (const f32x4*)(PS + (size_t)m * 64); float ss = 0.f;
#pragma unroll
                    for (int j = 0; j < 16; ++j) { const f32x4 v = ps[j]; ss += (v[0] + v[1]) + (v[2] + v[3]); }
                    RS2[m] = 1.0f / (ss * (1.f / DM) + RMS_EPS); } }
            VM_WAIT(); __syncthreads(); }
#if P9_DELAY > 0
        if ((bx >> 3) & 1) { for (int i = 0; i < P9_DELAY; ++i) __builtin_amdgcn_s_sleep(127); }
#endif
        pg8::EpiRelu2Scaled E{ACT, DFF, RS2};
        pg8::gemm_phase<pg8::EpiRelu2Scaled, pg8::UpOrder, P9_ALIGN, P9_SP2, P9_EPIREP>(ldsl + RING_OFF, g, S, E);
    }
    SEAM(9);
    if (IN(10)) {
        pg8::Gemm g{ACT, WDN, DFF, DFF, DFF}; pg8::PanelOrder<P10_PMR> S; S.init(MROWS, DM, G, bx);
#if H1_BF16
        pg8::EpiResidB E{U, out, DM};
        pg8::gemm_phase<pg8::EpiResidB, pg8::PanelOrder<P10_PMR>, true, true>(ldsl + RING_OFF, g, S, E);
#else
        pg8::EpiResid E{out, out, DM};
        pg8::gemm_phase<pg8::EpiResid, pg8::PanelOrder<P10_PMR>, true, true>(ldsl + RING_OFF, g, S, E);
#endif
    }
    SEAM(10);
    if (IN(11)) {
        for (int m = gw; m < MROWS; m += NGW) rms_row_inplace(out + (size_t)m * DM, g_fin, lane);
    }
#if defined(PROBE_ATT) && PROBE_ATT
    xcd_barrier(bar);
    { const att::Tensors T{PROJ, U, DL, relb, MASK, KN};
      const int vcu = (G % 8 == 0) ? (bx % 8) * (G / 8) + bx / 8 : bx;
      for (int u = vcu; u < 256; u += G) { const int bh = u >> 2, q = u & 3;
          for (int k = 0; k < 4; ++k) { const int qb = k == 0 ? 15 - q : (k == 1 ? 11 - q : (k == 2 ? 4 + q : q));
              att::attn_unit<1, PROBE_ATT - 1>((LAS char*)ldsl, T, att::Unit{bh >> 4, bh & 15, qb}); } } }
#endif
#if defined(PROBE_GEMM_L2) && PROBE_GEMM_L2
    xcd_barrier(bar);
#if PROBE_GEMM_L2 == 1
    { pg8::Gemm g{U, WUP, DM, DM, DM}; pg8::ProbeOrder S; S.init(MROWS, DFF, G, bx);
      pg8::EpiRelu2 E{ACT, DFF};
      pg8::gemm_phase<pg8::EpiRelu2, pg8::ProbeOrder, true, true, 1, PROBE_GEMM_MODE>(ldsl + RING_OFF, g, S, E); }
#else
    { pg8::Gemm g{ACT, WDN, DFF, DFF, DFF}; pg8::ProbeOrder S; S.init(MROWS, DM, G, bx);
      pg8::EpiRelu2 E{U, DM};
      pg8::gemm_phase<pg8::EpiRelu2, pg8::ProbeOrder, true, true, 1, PROBE_GEMM_MODE>(ldsl + RING_OFF, g, S, E); }
#endif
#endif
#undef IN
#undef SEAM
}

extern "C" void kernel_launch(void* const* d_in, const int* in_sizes, int n_in, void* d_out, int out_size, void* d_ws, size_t ws_size, hipStream_t stream) {
    static int grid = 0;
    if (grid == 0) {
        if (n_in != 13 || in_sizes[0] != MROWS * DM || out_size != MROWS * DM || ws_size < WS_END) { fprintf(stderr, "kernel_launch: unexpected shapes (n_in %d, in0 %d, out %d, ws %zu < %zu); nothing launched\n", n_in, n_in > 0 ? in_sizes[0] : -1, out_size, ws_size, (size_t)WS_END); grid = -1; return; }
        int dev = 0, cus = 0, per_cu = 0;
        if (hipGetDevice(&dev) != hipSuccess || hipDeviceGetAttribute(&cus, hipDeviceAttributeMultiprocessorCount, dev) != hipSuccess) { grid = -1; return; }
        if (hipFuncSetAttribute((const void*)fwd, hipFuncAttributeMaxDynamicSharedMemorySize, LDS_BYTES) != hipSuccess) { fprintf(stderr, "kernel_launch: hipFuncSetAttribute failed\n"); grid = -1; return; }
        if (hipOccupancyMaxActiveBlocksPerMultiprocessor(&per_cu, (const void*)fwd, NWAVES * 64, LDS_BYTES) != hipSuccess || per_cu < 1) { fprintf(stderr, "kernel_launch: occupancy query says %d blocks per CU\n", per_cu); }
        (void)hipGetLastError();
        grid = cus;
    }
    if (grid < 0) return;
    if (hipMemsetAsync((char*)d_ws + WS_CTL, 0, CTL_ZERO_BYTES, stream) != hipSuccess) return;
    Args a{};
    for (int i = 0; i < 13; ++i) a.in[i] = (const float*)d_in[i];
    a.out = (float*)d_out; a.ws = (unsigned char*)d_ws;
    for (int li = 0; li < N_LAUNCHES; ++li) {
        a.ph_lo = (N_LAUNCHES == 1) ? 0 : li; a.ph_hi = (N_LAUNCHES == 1) ? N_PHASES : li + 1;
        hipLaunchKernelGGL(fwd, dim3(grid), dim3(NWAVES * 64), LDS_BYTES, stream, a);
        const hipError_t le = hipPeekAtLastError();
        if (le != hipSuccess) { fprintf(stderr, "kernel_launch: launch %d failed: %s\n", li, hipGetErrorName(le)); break; }
    }
}
```

```cpp
#include <hip/hip_runtime.h>
#include <hip/hip_bf16.h>
#include <cstdio>
#include <cstdint>

#define GAS __attribute__((address_space(1)))
#define LAS __attribute__((address_space(3)))
typedef unsigned short bf16;
typedef unsigned v4u __attribute__((ext_vector_type(4)));
typedef float f32x4 __attribute__((ext_vector_type(4)));
typedef float f32x16 __attribute__((ext_vector_type(16)));
typedef short bf16x8 __attribute__((ext_vector_type(8)));
typedef short s16x4 __attribute__((ext_vector_type(4)));
typedef GAS unsigned gu32;
typedef GAS unsigned long long gu64;
typedef unsigned long long u64;
#define RLX_AGENT __ATOMIC_RELAXED, __HIP_MEMORY_SCOPE_AGENT
#define LDS_WAIT() asm volatile("s_waitcnt lgkmcnt(0)" ::: "memory")
#define VM_WAIT() asm volatile("s_waitcnt vmcnt(0)" ::: "memory")
#define SBAR() __builtin_amdgcn_sched_barrier(0)
__device__ __forceinline__ unsigned f2bf(float f) { unsigned u = __builtin_bit_cast(unsigned, f); return (u + 0x7fffu + ((u >> 16) & 1u)) >> 16; }
__device__ __forceinline__ unsigned pk2(float lo, float hi) { return f2bf(lo) | (f2bf(hi) << 16); }
__device__ __forceinline__ unsigned cvtpk(float lo, float hi) { unsigned r; asm volatile("v_cvt_pk_bf16_f32 %0, %1, %2" : "=v"(r) : "v"(lo), "v"(hi)); return r; }
__device__ __forceinline__ float bf2f(unsigned short b) { return __builtin_bit_cast(float, ((unsigned)b) << 16); }

constexpr int DM = 4096, NB = 4, LSEQ = 4096, MROWS = NB * LSEQ, MPAD = MROWS + 256;
constexpr int NMETA = 16, METAROW = MROWS + 48;
constexpr int HD = 128, NH = 16, WBR = NH * HD;
constexpr int HIDX = 32, DIDX = 64, KTOP = 256;
constexpr int DFF = 4 * DM;
constexpr int PP = 7 * 2048;
constexpr int C_QA = 0, C_KA = 2048, C_VA = 4096, C_QB = 6144, C_KB = 8192, C_VB = 10240, C_QI = 12288;
constexpr int NIN_TILES = 89, NIN = NIN_TILES * 256;
constexpr int DIN = 22640;
constexpr float RMS_EPS = 1e-6f;
constexpr float LOG2E = 1.4426950408889634f;
constexpr int NKT = LSEQ / 64 + 1;
constexpr int MASK_PITCH = 68;
constexpr int DL_PITCH = NKT * 64;
constexpr size_t SC_PER_BATCH = (size_t)2048 * 64 * 67;

namespace pg8 {
#define PG8_LAS __attribute__((address_space(3)))
typedef unsigned short bf16_t;
typedef short bf16x8 __attribute__((ext_vector_type(8)));
typedef float f32x4 __attribute__((ext_vector_type(4)));
typedef unsigned u32x4 __attribute__((ext_vector_type(4)));
constexpr int BM = 256, BK = 64, HALF = 128, HTB = HALF * BK * 2  , STAGE_BYTES = 8 * HTB, NXCD = 8, WGM = 8;

__host__ __device__ __forceinline__ int lds_byte(int r, int c) { const int st = (r >> 4) * 2 + (c >> 5), rr = r & 15, cc = c & 31, ob = rr * 64 + cc * 2; return st * 1024 + (ob ^ (((ob >> 9) & 1) << 5)); }
__host__ __device__ __forceinline__ void stage_rc(int b, int& R, int& C) { const int st = b / 1024, sb = b % 1024, swz = sb ^ (((sb >> 9) & 1) << 5); R = (st >> 1) * 16 + swz / 64; C = (st & 1) * 32 + (swz % 64) / 2; }
__host__ __device__ __forceinline__ int perm32(int rho) { const int n = rho >> 4, i = rho & 15; return 8 * (i >> 2) + 4 * n + (i & 3); }

struct Unit { int pm, pn; };
struct Gemm { const bf16_t* A; const bf16_t* Bt; int lda, ldb, K; };

struct StaticOrder {
    int nM, nN, nwg, G, c;
    __host__ __device__ void init(int M, int N, int G_, int c_) { nM = M / BM; nN = N / BM; nwg = nM * nN; G = G_; c = c_; }
    __host__ __device__ __forceinline__ bool next(int i, Unit& u) const {
        const long L = (long)i * G + c; if (L >= nwg) return false;
        int wgid = (int)L; { const int q = nwg / NXCD, r = nwg % NXCD, xcd = wgid % NXCD, off = wgid / NXCD; wgid = (xcd < r ? xcd * (q + 1) : r * (q + 1) + (xcd - r) * q) + off; }
        const int nig = WGM * nN, gid = wgid / nig, fm = gid * WGM, gsz = (nM - fm) < WGM ? (nM - fm) : WGM;
        u.pm = fm + ((wgid % nig) % gsz); u.pn = (wgid % nig) / gsz; return true;
    }
    __device__ __forceinline__ void a_ready(const Unit&) const {}
    __device__ __forceinline__ void done(const Unit&) const {}
};

#ifndef H1_BF16
#define H1_BF16 1
#endif
#ifndef EPI_NT
#define EPI_NT 0
#endif
#if EPI_NT
#define PG8_ST16(p, w) __builtin_nontemporal_store((w), (u32x4*)(p))
#else
#define PG8_ST16(p, w) (*(u32x4*)(p) = (w))
#endif
__device__ __forceinline__ unsigned cvt_pk_bf16(float lo, float hi) { unsigned r; asm volatile("v_cvt_pk_bf16_f32 %0, %1, %2" : "=v"(r) : "v"(lo), "v"(hi)); return r; }
__device__ __forceinline__ unsigned cvt_pk_bf16_t(float lo, float hi) { unsigned r; asm volatile("s_nop 0\n\tv_cvt_pk_bf16_f32 %0, %1, %2" : "=v"(r) : "v"(lo), "v"(hi)); return r; }

#ifndef W_OUT_FP8
#define W_OUT_FP8 1
#endif
#ifndef FP8_QK
#define FP8_QK 1
#endif
__host__ __device__ __forceinline__ constexpr int proj_bf16_tiles() { return FP8_QK ? 9 : 41; }
__host__ __device__ __forceinline__ constexpr int proj_fp8_tiles() { return FP8_QK ? 80 : 48; }
__host__ __device__ __forceinline__ int proj_bf16_tile(int j) { return FP8_QK ? (j < 8 ? 48 + j : 88) : (j < 16 ? j : (j < 32 ? j + 8 : (j < 40 ? j + 16 : 88))); }
__host__ __device__ __forceinline__ int proj_fp8_tile(int j) { return FP8_QK ? (j < 48 ? j : j + 8) : (j < 8 ? 16 + j : (j < 16 ? 32 + j : j + 40)); }
struct ProjOrder : StaticOrder {
    __device__ __forceinline__ bool next(int i, Unit& u) const {
        const long L = (long)i * G + c;
        if (L < nwg) { StaticOrder::next(i, u); u.pn = proj_bf16_tile(u.pn); return true; }
        const int e = (int)(L - nwg); if (e >= 33) return false;
        u.pm = 64; u.pn = e < 16 ? 8 + e : (e < 32 ? 32 + (e - 16) : 88); return true;
    }
};
struct Proj8Order : StaticOrder {
    __device__ __forceinline__ bool next(int i, Unit& u) const { if (!StaticOrder::next(i, u)) return false; u.pn = proj_fp8_tile(u.pn); return true; }
};

template <int PMR> struct PanelOrder : StaticOrder {
    __device__ __forceinline__ bool next(int i, Unit& u) const {
        if (G != 256 || nM != 64 || nN != 16) return StaticOrder::next(i, u);
        constexpr int PNR = 32 / PMR, NPH = 16 / PNR, ROUNDS = 4;
        if (i >= ROUNDS) return false;
        const int xcd = c & 7, r = c >> 3;
        const int slot = i * 8 + xcd;
        const int pgrp = slot / NPH, ph = slot % NPH;
        u.pm = pgrp * PMR + r / PNR; u.pn = ph * PNR + r % PNR; return true;
    }
};
struct UpOrder : StaticOrder {
    __device__ __forceinline__ bool next(int i, Unit& u) const {
        if (G != 256 || nM != 64 || nN != 64) return StaticOrder::next(i, u);
        if (i >= 16) return false;
        const int xcd = c & 7, r = c >> 3, sp = 3 - (i >> 2), j = i & 3;
        u.pm = 16 * sp + 8 * (xcd & 1) + (r & 7); u.pn = 16 * j + 4 * (xcd >> 1) + (r >> 3); return true;
    }
};
struct ProbeOrder : StaticOrder {
    __device__ __forceinline__ bool next(int i, Unit& u) const { const long L = (long)i * G + c; if (L >= nwg) return false; u.pm = 0; u.pn = 0; return true; }
};
struct EpiProj {
    static constexpr bool PERM = true, AFTER_DRAIN = false;
    bf16_t* PROJ; float* LF; bf16_t* KI; float* WI; const float* fbias;
    __device__ __forceinline__ void operator()(const f32x4 (&acc)[2][2][4][2], const Unit& u, int wr, int wc, int fr, int fq) const {
        const int row0 = u.pm * BM + wr * 64 + fr, c8 = wc * 32 + 8 * fq;
        if (u.pn < 88) {
            bf16_t* base = PROJ + (size_t)u.pn * BM + c8;
            const size_t ldc = 14336;
#pragma unroll
            for (int ai = 0; ai < 2; ++ai)
#pragma unroll
                for (int m = 0; m < 4; ++m) { bf16_t* rowp = base + (size_t)(row0 + ai * HALF + m * 16) * ldc;
#pragma unroll
                    for (int bj = 0; bj < 2; ++bj) { f32x4 v0 = acc[ai][bj][m][0], v1 = acc[ai][bj][m][1];
                        u32x4 w; w.x = cvt_pk_bf16(v0[0], v0[1]); w.y = cvt_pk_bf16(v0[2], v0[3]); w.z = cvt_pk_bf16(v1[0], v1[1]); w.w = cvt_pk_bf16(v1[2], v1[3]);
                        *(u32x4*)(rowp + bj * HALF) = w; } }
        } else {
#pragma unroll
            for (int ai = 0; ai < 2; ++ai)
#pragma unroll
                for (int m = 0; m < 4; ++m) { const size_t row = (size_t)(row0 + ai * HALF + m * 16); const f32x4 v0 = acc[ai][0][m][0], v1 = acc[ai][0][m][1];
                    if (c8 < 16) { f32x4 o0, o1;
#pragma unroll
                        for (int j = 0; j < 4; ++j) { const float z0 = v0[j] + fbias[c8 + j], z1 = v1[j] + fbias[c8 + 4 + j];
                            o0[j] = fminf(z0, 0.f) - log1pf(expf(-fabsf(z0))); o1[j] = fminf(z1, 0.f) - log1pf(expf(-fabsf(z1))); }
                        *(f32x4*)(LF + row * 16 + c8) = o0; *(f32x4*)(LF + row * 16 + c8 + 4) = o1; }
                    else if (c8 < 80) { u32x4 w; w.x = cvt_pk_bf16(v0[0], v0[1]); w.y = cvt_pk_bf16(v0[2], v0[3]); w.z = cvt_pk_bf16(v1[0], v1[1]); w.w = cvt_pk_bf16(v1[2], v1[3]);
                        *(u32x4*)(KI + row * 64 + (c8 - 16)) = w; }
                    else if (c8 < 112) { *(f32x4*)(WI + row * 32 + (c8 - 80)) = v0; *(f32x4*)(WI + row * 32 + (c8 - 80) + 4) = v1; } }
        }
    }
};
struct EpiProj8 {
    static constexpr bool PERM = true, AFTER_DRAIN = false;
    bf16_t* PROJ; bf16_t* G;
    __device__ __forceinline__ void operator()(const f32x4 (&acc)[2][2][4][2], const Unit& u, int wr, int wc, int fr, int fq) const {
        const int row0 = u.pm * BM + wr * 64 + fr, c8 = wc * 32 + 8 * fq;
        const bool gate = u.pn >= 56;
        bf16_t* base = gate ? G + (size_t)(u.pn - 56) * BM + c8 : PROJ + (size_t)u.pn * BM + c8;
        const size_t ldc = gate ? 8192 : 14336;
#pragma unroll
        for (int ai = 0; ai < 2; ++ai)
#pragma unroll
            for (int m = 0; m < 4; ++m) { bf16_t* rowp = base + (size_t)(row0 + ai * HALF + m * 16) * ldc;
#pragma unroll
                for (int bj = 0; bj < 2; ++bj) { f32x4 v0 = acc[ai][bj][m][0], v1 = acc[ai][bj][m][1];
                    if (gate) {
#pragma unroll
                        for (int j = 0; j < 4; ++j) { v0[j] = __builtin_amdgcn_rcpf(1.0f + __builtin_amdgcn_exp2f((-1.4426950408889634f / 64.f) * v0[j])); v1[j] = __builtin_amdgcn_rcpf(1.0f + __builtin_amdgcn_exp2f((-1.4426950408889634f / 64.f) * v1[j])); }
                    } else {
#pragma unroll
                        for (int j = 0; j < 4; ++j) { v0[j] *= (1.f / 64.f); v1[j] *= (1.f / 64.f); } }
                    u32x4 w; w.x = cvt_pk_bf16_t(v0[0], v0[1]); w.y = cvt_pk_bf16_t(v0[2], v0[3]); w.z = cvt_pk_bf16_t(v1[0], v1[1]); w.w = cvt_pk_bf16_t(v1[2], v1[3]);
                    PG8_ST16(rowp + bj * HALF, w); } }
    }
};
template <bool FIRST> struct EpiGate {
    static constexpr bool PERM = true, AFTER_DRAIN = false;
    bf16_t* MIX; const bf16_t* G; int gcol; unsigned char* M8; float asc;
    __device__ __forceinline__ void operator()(const f32x4 (&acc)[2][2][4][2], const Unit& u, int wr, int wc, int fr, int fq) const {
        const int row0 = u.pm * BM + wr * 64 + fr, col0 = u.pn * BM + wc * 32 + 8 * fq;
#pragma unroll
        for (int ai = 0; ai < 2; ++ai)
#pragma unroll
            for (int m = 0; m < 4; ++m) { const size_t row = (size_t)(row0 + ai * HALF + m * 16);
#pragma unroll
                for (int bj = 0; bj < 2; ++bj) { const int col = col0 + bj * HALF;
                    const u32x4 gv = *(const u32x4*)(G + row * 8192 + gcol + col);
                    f32x4 v0 = acc[ai][bj][m][0] * asc, v1 = acc[ai][bj][m][1] * asc;
                    v0[0] *= __builtin_bit_cast(float, gv.x << 16); v0[1] *= __builtin_bit_cast(float, gv.x & 0xffff0000u); v0[2] *= __builtin_bit_cast(float, gv.y << 16); v0[3] *= __builtin_bit_cast(float, gv.y & 0xffff0000u);
                    v1[0] *= __builtin_bit_cast(float, gv.z << 16); v1[1] *= __builtin_bit_cast(float, gv.z & 0xffff0000u); v1[2] *= __builtin_bit_cast(float, gv.w << 16); v1[3] *= __builtin_bit_cast(float, gv.w & 0xffff0000u);
                    if (!FIRST) { const u32x4 pv = *(const u32x4*)(MIX + row * 4096 + col);
                        v0[0] += __builtin_bit_cast(float, pv.x << 16); v0[1] += __builtin_bit_cast(float, pv.x & 0xffff0000u); v0[2] += __builtin_bit_cast(float, pv.y << 16); v0[3] += __builtin_bit_cast(float, pv.y & 0xffff0000u);
                        v1[0] += __builtin_bit_cast(float, pv.z << 16); v1[1] += __builtin_bit_cast(float, pv.z & 0xffff0000u); v1[2] += __builtin_bit_cast(float, pv.w << 16); v1[3] += __builtin_bit_cast(float, pv.w & 0xffff0000u); }
                    if (!FIRST && W_OUT_FP8) { int lo = 0, hi = 0;
                        lo = __builtin_amdgcn_cvt_pk_fp8_f32(16.f * v0[0], 16.f * v0[1], lo, false); lo = __builtin_amdgcn_cvt_pk_fp8_f32(16.f * v0[2], 16.f * v0[3], lo, true);
                        hi = __builtin_amdgcn_cvt_pk_fp8_f32(16.f * v1[0], 16.f * v1[1], hi, false); hi = __builtin_amdgcn_cvt_pk_fp8_f32(16.f * v1[2], 16.f * v1[3], hi, true);
                        *(unsigned long long*)(M8 + row * 4096 + col) = (unsigned long long)(unsigned)lo | ((unsigned long long)(unsigned)hi << 32); }
                    else { u32x4 w; w.x = cvt_pk_bf16(v0[0], v0[1]); w.y = cvt_pk_bf16(v0[2], v0[3]); w.z = cvt_pk_bf16(v1[0], v1[1]); w.w = cvt_pk_bf16(v1[2], v1[3]);
                        *(u32x4*)(MIX + row * 4096 + col) = w; } } }
    }
};
struct EpiResid {
    static constexpr bool PERM = false, AFTER_DRAIN = false;
    const float* base; float* out; int ldc;
    __device__ __forceinline__ void operator()(const f32x4 (&acc)[2][2][4][2], const Unit& u, int wr, int wc, int fr, int fq) const {
        const int row0 = u.pm * BM + wr * 64 + fr, col0 = u.pn * BM + wc * 32 + 4 * fq;
#pragma unroll
        for (int ai = 0; ai < 2; ++ai)
#pragma unroll
            for (int m = 0; m < 4; ++m) { const size_t off = (size_t)(row0 + ai * HALF + m * 16) * ldc + col0;
#pragma unroll
                for (int bj = 0; bj < 2; ++bj)
#pragma unroll
                    for (int n = 0; n < 2; ++n) { const f32x4 b = *(const f32x4*)(base + off + bj * HALF + n * 16); *(f32x4*)(out + off + bj * HALF + n * 16) = acc[ai][bj][m][n] + b; } }
    }
};
struct EpiResidB {
    static constexpr bool PERM = false, AFTER_DRAIN = false;
    const bf16_t* base; float* out; int ldc;
    __device__ __forceinline__ void operator()(const f32x4 (&acc)[2][2][4][2], const Unit& u, int wr, int wc, int fr, int fq) const {
        const int row0 = u.pm * BM + wr * 64 + fr, col0 = u.pn * BM + wc * 32 + 4 * fq;
#pragma unroll
        for (int ai = 0; ai < 2; ++ai)
#pragma unroll
            for (int m = 0; m < 4; ++m) { const size_t off = (size_t)(row0 + ai * HALF + m * 16) * ldc + col0;
#pragma unroll
                for (int bj = 0; bj < 2; ++bj)
#pragma unroll
                    for (int n = 0; n < 2; ++n) { const unsigned long long b = *(const unsigned long long*)(base + off + bj * HALF + n * 16);
                        const f32x4 bf = {__builtin_bit_cast(float, (unsigned)b << 16), __builtin_bit_cast(float, (unsigned)b & 0xffff0000u), __builtin_bit_cast(float, (unsigned)(b >> 32) << 16), __builtin_bit_cast(float, (unsigned)(b >> 32) & 0xffff0000u)};
                        *(f32x4*)(out + off + bj * HALF + n * 16) = acc[ai][bj][m][n] + bf; } }
    }
};
struct EpiResidHB {
    static constexpr bool PERM = true, AFTER_DRAIN = false;
    bf16_t* io; int ldc;
    __device__ __forceinline__ void operator()(const f32x4 (&acc)[2][2][4][2], const Unit& u, int wr, int wc, int fr, int fq) const {
        const int row0 = u.pm * BM + wr * 64 + fr, col0 = u.pn * BM + wc * 32 + 8 * fq;
#pragma unroll
        for (int ai = 0; ai < 2; ++ai)
#pragma unroll
            for (int m = 0; m < 4; ++m) { const size_t row = (size_t)(row0 + ai * HALF + m * 16);
#pragma unroll
                for (int bj = 0; bj < 2; ++bj) { const size_t off = row * ldc + col0 + bj * HALF; const u32x4 b = *(const u32x4*)(io + off);
                    const f32x4 h0 = acc[ai][bj][m][0] + (f32x4){__builtin_bit_cast(float, b.x << 16), __builtin_bit_cast(float, b.x & 0xffff0000u), __builtin_bit_cast(float, b.y << 16), __builtin_bit_cast(float, b.y & 0xffff0000u)};
                    const f32x4 h1 = acc[ai][bj][m][1] + (f32x4){__builtin_bit_cast(float, b.z << 16), __builtin_bit_cast(float, b.z & 0xffff0000u), __builtin_bit_cast(float, b.w << 16), __builtin_bit_cast(float, b.w & 0xffff0000u)};
                    u32x4 w; w.x = cvt_pk_bf16(h0[0], h0[1]); w.y = cvt_pk_bf16(h0[2], h0[3]); w.z = cvt_pk_bf16(h1[0], h1[1]); w.w = cvt_pk_bf16(h1[2], h1[3]);
                    *(u32x4*)(io + off) = w; } }
    }
};
struct EpiResidNorm {
    static constexpr bool PERM = true, AFTER_DRAIN = false;
    const float* base; float* out; bf16_t* A2; const float* gain; float* PS; int ldc; float asc;
    __device__ __forceinline__ void operator()(const f32x4 (&acc)[2][2][4][2], const Unit& u, int wr, int wc, int fr, int fq) const {
        const int row0 = u.pm * BM + wr * 64 + fr, col0 = u.pn * BM + wc * 32 + 8 * fq;
        f32x4 gv[2][2];
#pragma unroll
        for (int bj = 0; bj < 2; ++bj) { gv[bj][0] = *(const f32x4*)(gain + col0 + bj * HALF); gv[bj][1] = *(const f32x4*)(gain + col0 + bj * HALF + 4); }
#pragma unroll
        for (int ai = 0; ai < 2; ++ai)
#pragma unroll
            for (int m = 0; m < 4; ++m) { const size_t row = (size_t)(row0 + ai * HALF + m * 16); float ss = 0.f;
#pragma unroll
                for (int bj = 0; bj < 2; ++bj) { const size_t off = row * ldc + col0 + bj * HALF;
                    const f32x4 h0 = acc[ai][bj][m][0] * asc + *(const f32x4*)(base + off), h1 = acc[ai][bj][m][1] * asc + *(const f32x4*)(base + off + 4);
                    if (!H1_BF16) { *(f32x4*)(out + off) = h0; *(f32x4*)(out + off + 4) = h1; }
                    ss += (h0[0] * h0[0] + h0[1] * h0[1]) + (h0[2] * h0[2] + h0[3] * h0[3]) + (h1[0] * h1[0] + h1[1] * h1[1]) + (h1[2] * h1[2] + h1[3] * h1[3]);
                    const f32x4 a0 = H1_BF16 ? h0 : h0 * gv[bj][0], a1 = H1_BF16 ? h1 : h1 * gv[bj][1];
                    u32x4 w; w.x = cvt_pk_bf16(a0[0], a0[1]); w.y = cvt_pk_bf16(a0[2], a0[3]); w.z = cvt_pk_bf16(a1[0], a1[1]); w.w = cvt_pk_bf16(a1[2], a1[3]);
                    *(u32x4*)(A2 + off) = w; }
                ss += __shfl_xor(ss, 16); ss += __shfl_xor(ss, 32);
                if (fq == 0) PS[row * 64 + u.pn * 4 + wc] = ss; }
    }
};
struct EpiRelu2Scaled {
    static constexpr bool PERM = true, AFTER_DRAIN = false;
    bf16_t* O; int ldc; const float* RS2;
    __device__ __forceinline__ void operator()(const f32x4 (&acc)[2][2][4][2], const Unit& u, int wr, int wc, int fr, int fq) const {
        const int row0 = u.pm * BM + wr * 64 + fr, col0 = u.pn * BM + wc * 32 + 8 * fq;
#pragma unroll
        for (int ai = 0; ai < 2; ++ai)
#pragma unroll
            for (int m = 0; m < 4; ++m) { const int row = row0 + ai * HALF + m * 16; const float s2 = RS2[row]; bf16_t* rowp = O + (size_t)row * ldc + col0;
#pragma unroll
                for (int bj = 0; bj < 2; ++bj) { f32x4 v0 = acc[ai][bj][m][0], v1 = acc[ai][bj][m][1];
#pragma unroll
                    for (int j = 0; j < 4; ++j) { const float a = fmaxf(v0[j], 0.f), b = fmaxf(v1[j], 0.f); v0[j] = a * a * s2; v1[j] = b * b * s2; }
                    u32x4 w; w.x = cvt_pk_bf16(v0[0], v0[1]); w.y = cvt_pk_bf16(v0[2], v0[3]); w.z = cvt_pk_bf16(v1[0], v1[1]); w.w = cvt_pk_bf16(v1[2], v1[3]);
                    PG8_ST16(rowp + bj * HALF, w); } }
    }
};
struct EpiRelu2 {
    static constexpr bool PERM = true, AFTER_DRAIN = false;
    bf16_t* O; int ldc;
    __device__ __forceinline__ void operator()(const f32x4 (&acc)[2][2][4][2], const Unit& u, int wr, int wc, int fr, int fq) const {
        const int row0 = u.pm * BM + wr * 64 + fr, col0 = u.pn * BM + wc * 32 + 8 * fq;
#pragma unroll
        for (int ai = 0; ai < 2; ++ai)
#pragma unroll
            for (int m = 0; m < 4; ++m) { bf16_t* rowp = O + (size_t)(row0 + ai * HALF + m * 16) * ldc + col0;
#pragma unroll
                for (int bj = 0; bj < 2; ++bj) { f32x4 v0 = acc[ai][bj][m][0], v1 = acc[ai][bj][m][1];
#pragma unroll
                    for (int j = 0; j < 4; ++j) { const float a = fmaxf(v0[j], 0.f), b = fmaxf(v1[j], 0.f); v0[j] = a * a; v1[j] = b * b; }
                    u32x4 w; w.x = cvt_pk_bf16(v0[0], v0[1]); w.y = cvt_pk_bf16(v0[2], v0[3]); w.z = cvt_pk_bf16(v1[0], v1[1]); w.w = cvt_pk_bf16(v1[2], v1[3]);
                    *(u32x4*)(rowp + bj * HALF) = w; } }
    }
};

template <class Epi, class Sched, bool ALIGN_EPI = false, bool SP2 = false, int EPIREP = 1, int PROBE = 0, bool FP8 = false>
__device__ __forceinline__ void gemm_phase(PG8_LAS unsigned char* lds, const Gemm g, const Sched& S, const Epi& E) {
    const int tid = threadIdx.x, wid = __builtin_amdgcn_readfirstlane(tid >> 6), lane = tid & 63, wr = wid >> 2, wc = wid & 3, fr = lane & 15, fq = lane >> 4;
    const int K = g.K, nt = K / BK;
    unsigned voffA[2], voffB[2];
#pragma unroll
    for (int i = 0; i < 2; ++i) { int R, C; stage_rc(tid * 16 + i * 8192, R, C); const int Rb = Epi::PERM ? ((R & ~31) + perm32(R & 31)) : R;
        voffA[i] = (unsigned)(R * g.lda + C) * 2u; voffB[i] = (unsigned)(Rb * g.ldb + C) * 2u; }
    const size_t kstep = (size_t)(BK * 2);
    const size_t hstepA = (size_t)HALF * g.lda * 2, hstepB = (size_t)HALF * g.ldb * 2;
    const size_t tstepA = 2 * hstepA, tstepB = 2 * hstepB;
    const size_t qs_voffA = (size_t)64 * g.lda * 2, qs_voffB = (size_t)64 * g.ldb * 2;
    const unsigned ldsw = (unsigned)wid * 1024u;
    int aoff = lds_byte(wr * 64 + fr, fq * 8), boff = lds_byte(wc * 32 + fr, fq * 8);
#define PG8_SA(b, h) (((b) * 2 + (h)) * HTB)
#define PG8_SB(b, h) ((4 + (b) * 2 + (h)) * HTB)
#define PG8_STAGE(bufoff, gbase, voff) do { if (PROBE == 1) break; _Pragma("unroll") for (int _i = 0; _i < 2; ++_i) \
        __builtin_amdgcn_global_load_lds((const unsigned*)((const char*)(gbase) + (FP8 ? (size_t)_i * qs_##voff : (size_t)0) + (voff)[FP8 ? 0 : _i]), (PG8_LAS unsigned*)(lds + (bufoff) + ldsw + _i * 8192), 16, 0, 0); } while (0)
#define PG8_LDA(dst, b, h) do { if (PROBE == 1) { asm volatile("" : "+v"(dst[0][0]), "+v"(dst[1][0]), "+v"(dst[2][1]), "+v"(dst[3][1])); break; } _Pragma("unroll") for (int m = 0; m < 4; ++m) _Pragma("unroll") for (int k = 0; k < 2; ++k) dst[m][k] = *(const PG8_LAS bf16x8*)(lds + PG8_SA(b, h) + aoff + m * 2048 + k * 1024); } while (0)
#define PG8_LDB(dst, b, h) do { if (PROBE == 1) { asm volatile("" : "+v"(dst[0][0]), "+v"(dst[1][1])); break; } _Pragma("unroll") for (int n = 0; n < 2; ++n) _Pragma("unroll") for (int k = 0; k < 2; ++k) dst[n][k] = *(const PG8_LAS bf16x8*)(lds + PG8_SB(b, h) + boff + n * 2048 + k * 1024); } while (0)
#define PG8_MMA(ai, bj, At, Bt) do { __builtin_amdgcn_s_setprio(1); _Pragma("unroll") for (int m = 0; m < 4; ++m) _Pragma("unroll") for (int n = 0; n < 2; ++n) { \
        if constexpr (FP8) { typedef int i32x4_ __attribute__((ext_vector_type(4))); typedef int i32x8_ __attribute__((ext_vector_type(8)));                        \
            const i32x8_ a8_ = __builtin_shufflevector(__builtin_bit_cast(i32x4_, At[m][0]), __builtin_bit_cast(i32x4_, At[m][1]), 0, 1, 2, 3, 4, 5, 6, 7);          \
            const i32x8_ b8_ = __builtin_shufflevector(__builtin_bit_cast(i32x4_, Bt[n][0]), __builtin_bit_cast(i32x4_, Bt[n][1]), 0, 1, 2, 3, 4, 5, 6, 7);          \
            asm volatile("v_mfma_scale_f32_16x16x128_f8f6f4 %0, %1, %2, %0, %3, %3 op_sel_hi:[0,0,0]" : "+v"(acc[ai][bj][m][n]) : "v"(b8_), "v"(a8_), "v"(sc8_)); }   \
        else { _Pragma("unroll") for (int k = 0; k < 2; ++k) acc[ai][bj][m][n] = __builtin_amdgcn_mfma_f32_16x16x32_bf16(Bt[n][k], At[m][k], acc[ai][bj][m][n], 0, 0, 0); } } \
        __builtin_amdgcn_s_setprio(0); } while (0)
#define PG8_WAIT_V(n) do { if (PROBE != 1) asm volatile("s_waitcnt vmcnt(" #n ")" ::: "memory"); } while (0)
#define PG8_WAIT_L(n) do { if (PROBE != 1) asm volatile("s_waitcnt lgkmcnt(" #n ")" ::: "memory"); } while (0)
#define PG8_BAR __builtin_amdgcn_s_barrier()
#define PG8_SCHED __builtin_amdgcn_sched_barrier(0)
#ifndef PG8_DRAIN_NOPS
#define PG8_DRAIN_NOPS 0
#endif
#define PG8_DRAIN do { if constexpr (FP8 && PG8_DRAIN_NOPS > 0) { _Pragma("unroll") for (int _d = 0; _d < PG8_DRAIN_NOPS; ++_d) asm volatile("s_nop 15" ::: "memory"); } } while (0)
    Unit cur, nxt; int ui = 0;
    if (!S.next(0, cur)) return;
    int sc8_ = 0x7f7f7f7f; if constexpr (FP8) { asm volatile("" : "+v"(sc8_)); }
    f32x4 acc[2][2][4][2];
#pragma unroll
    for (int a = 0; a < 2; ++a)
#pragma unroll
        for (int b = 0; b < 2; ++b)
#pragma unroll
            for (int m = 0; m < 4; ++m)
#pragma unroll
                for (int n = 0; n < 2; ++n) acc[a][b][m][n] = (f32x4){0.f, 0.f, 0.f, 0.f};
    bf16x8 At[4][2], B0[2][2], B1[2][2];
    if (PROBE == 1) {
        unsigned hsh = (unsigned)(tid * 2654435761u);
#pragma unroll
        for (int m = 0; m < 4; ++m)
#pragma unroll
            for (int k = 0; k < 2; ++k)
#pragma unroll
                for (int e = 0; e < 8; ++e) { hsh = hsh * 1664525u + 1013904223u; At[m][k][e] = (short)(0x3f00u | ((hsh >> 16) & 0x80ffu)); }
#pragma unroll
        for (int n = 0; n < 2; ++n)
#pragma unroll
            for (int k = 0; k < 2; ++k)
#pragma unroll
                for (int e = 0; e < 8; ++e) { hsh = hsh * 1664525u + 1013904223u; B0[n][k][e] = (short)(0x3f00u | ((hsh >> 16) & 0x80ffu)); hsh = hsh * 1664525u + 1013904223u; B1[n][k][e] = (short)(0x3f00u | ((hsh >> 16) & 0x80ffu)); }
    }
    const char* cA = (const char*)g.A + (size_t)cur.pm * tstepA; const char* cB = (const char*)g.Bt + (size_t)cur.pn * tstepB;
    S.a_ready(cur);
    if constexpr (SP2) {
        PG8_STAGE(PG8_SB(0, 0), cB, voffB); PG8_STAGE(PG8_SB(0, 1), cB + hstepB, voffB); PG8_STAGE(PG8_SA(0, 0), cA, voffA); PG8_STAGE(PG8_SA(0, 1), cA + hstepA, voffA);
        if (wr == 1) PG8_BAR;
        PG8_WAIT_V(2); PG8_BAR;
        PG8_STAGE(PG8_SB(1, 0), cB + kstep, voffB); PG8_STAGE(PG8_SA(1, 0), cA + kstep, voffA); PG8_STAGE(PG8_SB(1, 1), cB + hstepB + kstep, voffB);
        PG8_WAIT_V(6); PG8_BAR;
    } else {
        PG8_STAGE(PG8_SB(0, 0), cB, voffB); PG8_STAGE(PG8_SA(0, 0), cA, voffA); PG8_STAGE(PG8_SB(0, 1), cB + hstepB, voffB); PG8_STAGE(PG8_SA(0, 1), cA + hstepA, voffA);
        if (wr == 1) PG8_BAR;
        PG8_WAIT_V(4); PG8_BAR;
        PG8_STAGE(PG8_SB(1, 0), cB + kstep, voffB); PG8_STAGE(PG8_SA(1, 0), cA + kstep, voffA); PG8_STAGE(PG8_SB(1, 1), cB + hstepB + kstep, voffB);
        PG8_WAIT_V(6); PG8_BAR;
    }
    for (;;) {
        const bool has_next = S.next(ui + 1, nxt);
        const char* nA = has_next ? (const char*)g.A + (size_t)nxt.pm * tstepA : cA; const char* nB = has_next ? (const char*)g.Bt + (size_t)nxt.pn * tstepB : cB;
        for (int t = 0; t < nt; t += 2) {
            if constexpr (FP8) { asm volatile("" : "+v"(aoff), "+v"(boff), "+v"(voffA[0]), "+v"(voffB[0])); }
            const bool last = (t == nt - 2);
            const char* a1 = cA + (size_t)(t + 1) * kstep;
            const char* a2 = last ? nA : cA + (size_t)(t + 2) * kstep; const char* b2 = last ? nB : cB + (size_t)(t + 2) * kstep;
            const char* a3 = a2 + kstep; const char* b3 = b2 + kstep;
            if (last && has_next) S.a_ready(nxt);
            if constexpr (SP2) {
            PG8_LDB(B0, 0, 0); PG8_LDB(B1, 0, 1); PG8_SCHED; PG8_LDA(At, 0, 0); PG8_STAGE(PG8_SA(1, 1), a1 + hstepA, voffA);
            PG8_WAIT_V(8); PG8_WAIT_L(0); PG8_BAR; PG8_MMA(0, 0, At, B0); PG8_MMA(0, 1, At, B1); PG8_BAR; PG8_DRAIN; PG8_SCHED;
            PG8_LDA(At, 0, 1); PG8_STAGE(PG8_SB(0, 0), b2, voffB); PG8_STAGE(PG8_SB(0, 1), b2 + hstepB, voffB); PG8_STAGE(PG8_SA(0, 0), a2, voffA);
            PG8_WAIT_V(8); PG8_WAIT_L(0); PG8_BAR; PG8_MMA(1, 0, At, B0); PG8_MMA(1, 1, At, B1); PG8_BAR; PG8_DRAIN; PG8_SCHED;
            PG8_LDB(B0, 1, 0); PG8_LDB(B1, 1, 1); PG8_SCHED; PG8_LDA(At, 1, 0); PG8_STAGE(PG8_SA(0, 1), a2 + hstepA, voffA);
            PG8_WAIT_V(8); PG8_WAIT_L(0); PG8_BAR; PG8_MMA(0, 0, At, B0); PG8_MMA(0, 1, At, B1); PG8_BAR; PG8_DRAIN; PG8_SCHED;
            PG8_LDA(At, 1, 1); PG8_STAGE(PG8_SB(1, 0), b3, voffB); PG8_STAGE(PG8_SB(1, 1), b3 + hstepB, voffB); PG8_STAGE(PG8_SA(1, 0), a3, voffA);
            PG8_WAIT_V(8); PG8_WAIT_L(0); PG8_BAR; PG8_MMA(1, 0, At, B0); PG8_MMA(1, 1, At, B1); PG8_BAR; PG8_DRAIN; PG8_SCHED;
            } else {
            PG8_LDB(B0, 0, 0); PG8_SCHED; PG8_LDA(At, 0, 0); PG8_STAGE(PG8_SA(1, 1), a1 + hstepA, voffA);
            PG8_WAIT_L(8); PG8_BAR; PG8_WAIT_L(0); PG8_MMA(0, 0, At, B0); PG8_BAR; PG8_SCHED;
            PG8_LDB(B1, 0, 1); PG8_STAGE(PG8_SB(0, 0), b2, voffB);
            PG8_BAR; PG8_WAIT_L(0); PG8_MMA(0, 1, At, B1); PG8_BAR;
            PG8_LDA(At, 0, 1); PG8_STAGE(PG8_SA(0, 0), a2, voffA);
            PG8_BAR; PG8_WAIT_L(0); PG8_MMA(1, 0, At, B0); PG8_BAR; PG8_SCHED;
            PG8_STAGE(PG8_SB(0, 1), b2 + hstepB, voffB);
            PG8_WAIT_V(6); PG8_BAR; PG8_MMA(1, 1, At, B1); PG8_BAR;
            PG8_LDB(B0, 1, 0); PG8_SCHED; PG8_LDA(At, 1, 0); PG8_STAGE(PG8_SA(0, 1), a2 + hstepA, voffA);
            PG8_WAIT_L(8); PG8_BAR; PG8_WAIT_L(0); PG8_MMA(0, 0, At, B0); PG8_BAR; PG8_SCHED;
            PG8_LDB(B1, 1, 1); PG8_STAGE(PG8_SB(1, 0), b3, voffB);
            PG8_BAR; PG8_WAIT_L(0); PG8_MMA(0, 1, At, B1); PG8_BAR;
            PG8_LDA(At, 1, 1); PG8_STAGE(PG8_SA(1, 0), a3, voffA);
            PG8_BAR; PG8_WAIT_L(0); PG8_MMA(1, 0, At, B0); PG8_BAR; PG8_SCHED;
            PG8_STAGE(PG8_SB(1, 1), b3 + hstepB, voffB);
            PG8_WAIT_V(6); PG8_BAR; PG8_MMA(1, 1, At, B1); PG8_BAR;
            }
        }
        if constexpr (FP8) { asm volatile("s_nop 15" ::: "memory"); }
        if constexpr (ALIGN_EPI) { if (wr == 0) PG8_BAR; }
        if constexpr (!Epi::AFTER_DRAIN) { int fr_ = fr, fq_ = fq; if constexpr (FP8) { int l_ = threadIdx.x; asm volatile("" : "+v"(l_)); fr_ = l_ & 15; fq_ = (l_ >> 4) & 3; }
            E(acc, cur, wr, wc, fr_, fq_); if constexpr (EPIREP > 1) { asm volatile("" ::: "memory"); E(acc, cur, wr, wc, fr_, fq_); } S.done(cur); }
        if (!has_next) break;
#pragma unroll
        for (int a = 0; a < 2; ++a)
#pragma unroll
            for (int b = 0; b < 2; ++b)
#pragma unroll
                for (int m = 0; m < 4; ++m)
#pragma unroll
                    for (int n = 0; n < 2; ++n) acc[a][b][m][n] = (f32x4){0.f, 0.f, 0.f, 0.f};
        cur = nxt; cA = nA; cB = nB; ++ui;
        if constexpr (ALIGN_EPI) { if (wr == 1) PG8_BAR; }
    }
    PG8_WAIT_V(0);
    if constexpr (!ALIGN_EPI) { if (wr == 0) PG8_BAR; }
    PG8_BAR;
    if constexpr (Epi::AFTER_DRAIN) { E.fused(acc, cur, wr, wc, fr, fq, lds, wid, lane); S.done(cur); }
#undef PG8_SA
#undef PG8_SB
#undef PG8_STAGE
#undef PG8_LDA
#undef PG8_LDB
#undef PG8_MMA
#undef PG8_WAIT_V
#undef PG8_WAIT_L
#undef PG8_BAR
#undef PG8_SCHED
#undef PG8_DRAIN
}
}


namespace att {
constexpr int QBLK = 32, KVBLK = 64, QB = 256, SHM_V = KVBLK * HD * 2, SHM_K = KVBLK * HD * 2;
constexpr int LDS_WS = 2 * SHM_V + 2 * SHM_K, LDS_AUX = LDS_WS + 8 * 64 * 4, LDS_FLAGS = LDS_AUX + DL_PITCH * 4, ATT_LDS_BYTES = LDS_FLAGS + 64;
constexpr float C2 = 0.08838834764831845f * LOG2E;
constexpr float THRL = 8.0f;
constexpr float SKIP_MARGIN = 40.0f;
#define KSWZ(row, colB) ((row) * 256 + ((colB) ^ (((row) & 7) << 4)))
__device__ __forceinline__ int v_st(int k, int c) { const int kk = (k & ~0xC) | ((k & 4) << 1) | ((k & 8) >> 1); return ((kk >> 3) * 4 + (c >> 5)) * 512 + ((kk & 7) * 32 + (c & 31)) * 2; }
__device__ __forceinline__ int v_rd_base(int lane) { return ((lane & 3) << 3) | (((lane >> 2) & 3) << 6) | (((lane >> 4) & 1) << 5) | (((lane >> 5) & 1) << 8); }
constexpr int v_rd_off(int d0, int ks, int half) { return d0 * 512 + ks * 4096 + half * 2048; }
__device__ __forceinline__ int crow(int r, int hi) { return (r & 3) + 8 * (r >> 2) + 4 * hi; }

template <int KB>
__device__ __forceinline__ void qkt(f32x16& p0, f32x16& p1, const LAS char* K_lds, int r32, int hi, const bf16x8* qr) {
    p0 = f32x16{}; p1 = f32x16{};
    const LAS char* kb[4];
#pragma unroll
    for (int dd = 0; dd < 4; ++dd) kb[dd] = K_lds + KB * SHM_K + KSWZ(r32, (dd * 16 + hi * 8) * 2);
#pragma unroll
    for (int d0 = 0; d0 < 8; ++d0) { const LAS char* a = kb[d0 & 3] + (d0 >> 2) * 128;
        bf16x8 b0 = *(const LAS bf16x8*)(a);
        bf16x8 b1 = *(const LAS bf16x8*)(a + 32 * 256);
        p0 = __builtin_amdgcn_mfma_f32_32x32x16_bf16(b0, qr[d0], p0, 0, 0, 0);
        p1 = __builtin_amdgcn_mfma_f32_32x32x16_bf16(b1, qr[d0], p1, 0, 0, 0);
        if (d0 == 3) SBAR(); }
}
template <int VB>
__device__ __forceinline__ void pv_tile(f32x16* o, int vb0, bf16x8 pa0, bf16x8 pa1, bf16x8 pa2, bf16x8 pa3) {
#define TRRD(dst, off) asm volatile("ds_read_b64_tr_b16 %0, %1 offset:%2" : "=&v"(dst) : "v"(vb0), "i"(off) : "memory")
#define PV_D0(d0) do { s16x4 l0, l1, l2, l3, h0, h1, h2, h3; constexpr int b_ = VB * SHM_V + v_rd_off(d0, 0, 0);     \
        TRRD(l0, b_); TRRD(h0, b_ + 2048); TRRD(l1, b_ + 4096); TRRD(h1, b_ + 6144); TRRD(l2, b_ + 8192); TRRD(h2, b_ + 10240); TRRD(l3, b_ + 12288); TRRD(h3, b_ + 14336); \
        asm volatile("s_waitcnt lgkmcnt(0)" ::: "memory"); SBAR();                 \
        o[d0] = __builtin_amdgcn_mfma_f32_32x32x16_bf16(pa0, (bf16x8){l0[0], l0[1], l0[2], l0[3], h0[0], h0[1], h0[2], h0[3]}, o[d0], 0, 0, 0);   \
        o[d0] = __builtin_amdgcn_mfma_f32_32x32x16_bf16(pa1, (bf16x8){l1[0], l1[1], l1[2], l1[3], h1[0], h1[1], h1[2], h1[3]}, o[d0], 0, 0, 0);   \
        o[d0] = __builtin_amdgcn_mfma_f32_32x32x16_bf16(pa2, (bf16x8){l2[0], l2[1], l2[2], l2[3], h2[0], h2[1], h2[2], h2[3]}, o[d0], 0, 0, 0);   \
        o[d0] = __builtin_amdgcn_mfma_f32_32x32x16_bf16(pa3, (bf16x8){l3[0], l3[1], l3[2], l3[3], h3[0], h3[1], h3[2], h3[3]}, o[d0], 0, 0, 0); } while (0)
    PV_D0(0); PV_D0(1); PV_D0(2); PV_D0(3);
#undef PV_D0
#undef TRRD
}
__device__ __forceinline__ void partialSM(f32x16& p0, f32x16& p1, float& m_reg, float& alpha) {
    float pmax = p0[0];
#pragma unroll
    for (int r = 1; r < 16; ++r) pmax = fmaxf(pmax, p0[r]);
#pragma unroll
    for (int r = 0; r < 16; ++r) pmax = fmaxf(pmax, p1[r]);
    { auto rr = __builtin_amdgcn_permlane32_swap(__float_as_uint(pmax), __float_as_uint(pmax), false, false);
      pmax = fmaxf(__uint_as_float(rr[0]), __uint_as_float(rr[1])); }
    float mn;
    if (__builtin_expect(__all((pmax - m_reg) <= THRL), 1)) { mn = m_reg; alpha = 1.f; }
    else { mn = fmaxf(m_reg, pmax); alpha = __builtin_amdgcn_exp2f(m_reg - mn); m_reg = mn; }
#pragma unroll
    for (int r = 0; r < 16; ++r) { p0[r] = __builtin_amdgcn_exp2f(p0[r] - mn); p1[r] = p1[r] - mn; }
}
__device__ __forceinline__ void finishSM(f32x16& p0, f32x16& p1, float alpha, float& l_reg, bf16x8& pa0, bf16x8& pa1, bf16x8& pa2, bf16x8& pa3) {
#pragma unroll
    for (int r = 0; r < 16; ++r) p1[r] = __builtin_amdgcn_exp2f(p1[r]);
    float ps = 0;
#pragma unroll
    for (int r = 0; r < 16; ++r) ps += p0[r];
#pragma unroll
    for (int r = 0; r < 16; ++r) ps += p1[r];
    { auto rr = __builtin_amdgcn_permlane32_swap(__float_as_uint(ps), __float_as_uint(ps), false, false);
      ps = __uint_as_float(rr[0]) + __uint_as_float(rr[1]); }
    l_reg = l_reg * alpha + ps;
#define PK4(P, B_, OUT) do { unsigned a0 = cvtpk(P[B_+0], P[B_+1]), a1 = cvtpk(P[B_+2], P[B_+3]);                          \
        unsigned b0 = cvtpk(P[B_+4], P[B_+5]), b1 = cvtpk(P[B_+6], P[B_+7]);                                             \
        auto r0 = __builtin_amdgcn_permlane32_swap(a0, b0, false, false); auto r1 = __builtin_amdgcn_permlane32_swap(a1, b1, false, false); \
        v4u w = {r0[0], r1[0], r0[1], r1[1]}; OUT = *reinterpret_cast<bf16x8*>(&w); } while (0)
    PK4(p0, 0, pa0); PK4(p0, 8, pa1); PK4(p1, 0, pa2); PK4(p1, 8, pa3);
#undef PK4
}
__device__ __forceinline__ int t5_bucket(int rel) {
    const int n = rel < 0 ? -rel : rel; int b;
    if (n < 8) b = n; else { const int k = (31 - __builtin_clz((unsigned)(n * n))) - 6; b = 8 + k; if (b > 15) b = 15; }
    return b + (rel > 0 ? 16 : 0);
}

struct Unit { int b, h, qb; };
struct Tensors { const bf16* PROJ; bf16* O; const float* DL; const float* relb; const u64* MASK; const float* KN; };

template <int MODE, int NOSM = 0>
__device__ __forceinline__ void attn_unit(LAS char* lds, const Tensors& T, const Unit& U) {
    const int tid = threadIdx.x, wid = __builtin_amdgcn_readfirstlane(tid >> 6), lane = tid & 63, r32 = lane & 31, hi = lane >> 5;
    const int P0 = U.qb * QB, jhi = P0 / KVBLK + 4;
    const int qlo = P0 + wid * QBLK, qi = qlo + r32;
    constexpr int CQ = MODE == 0 ? C_QA : C_QB, CK = MODE == 0 ? C_KA : C_KB, CV = MODE == 0 ? C_VA : C_VB;
    const bf16* Qp = T.PROJ + (size_t)(U.b * LSEQ + P0) * PP + CQ + U.h * HD;
    const bf16* Kb = T.PROJ + (size_t)(U.b * LSEQ) * PP + CK + U.h * HD;
    const bf16* Vb = T.PROJ + (size_t)(U.b * LSEQ) * PP + CV + U.h * HD;
    const bf16* Km = T.PROJ + (size_t)MROWS * PP + CK + U.h * HD;
    const bf16* Vm = T.PROJ + (size_t)MROWS * PP + CV + U.h * HD;
    LAS char* V_lds = lds; LAS char* K_lds = lds + 2 * SHM_V;
    LAS float* ws = (LAS float*)(lds + LDS_WS) + wid * 64; LAS float* li_l = ws; LAS float* al_l = ws + 32;
    LAS float* aux = (LAS float*)(lds + LDS_AUX);
    const int vb0 = (int)(size_t)V_lds + v_rd_base(lane);
    unsigned kofs, vofs;
    { const int row = wid * 4 + (lane >> 4), chunk = (lane & 15) ^ (row & 7); kofs = (unsigned)(row * PP + chunk * 8) * 2u;
      const int s0 = 2 * wid + (lane >> 5), kk = (s0 >> 2) * 8 + ((lane & 31) >> 2), key = (kk & ~0xC) | ((kk & 4) << 1) | ((kk & 8) >> 1), cc = (s0 & 3) * 32 + (lane & 3) * 8;
      vofs = (unsigned)(key * PP + cc) * 2u; }
#define KTILE(t) ((t) < 0 ? Km : Kb + (size_t)(t) * KVBLK * PP)
#define VTILE(t) ((t) < 0 ? Vm : Vb + (size_t)(t) * KVBLK * PP)
#define DMA_K(t, bf) do { const char* kp_ = (const char*)(KTILE(t));                                                          \
        __builtin_amdgcn_global_load_lds((const unsigned*)(kp_ + (size_t)kofs), (LAS unsigned*)(K_lds + (bf) * SHM_K + wid * 1024), 16, 0, 0);                                   \
        __builtin_amdgcn_global_load_lds((const unsigned*)(kp_ + (size_t)32 * PP * 2 + (size_t)kofs), (LAS unsigned*)(K_lds + (bf) * SHM_K + 8192 + wid * 1024), 16, 0, 0); } while (0)
#define DMA_V(t, bf) do { const char* vp_ = (const char*)(VTILE(t));                                                                                                             \
        __builtin_amdgcn_global_load_lds((const unsigned*)(vp_ + (size_t)vofs), (LAS unsigned*)(V_lds + (bf) * SHM_V + wid * 1024), 16, 0, 0);                                   \
        __builtin_amdgcn_global_load_lds((const unsigned*)(vp_ + (size_t)32 * PP * 2 + (size_t)vofs), (LAS unsigned*)(V_lds + (bf) * SHM_V + 8192 + wid * 1024), 16, 0, 0); } while (0)
#define TILE(k) (jhi - 1 - (k))
    DMA_K(TILE(0), 0); DMA_V(TILE(0), 0);
    bf16x8 qr[8];
#pragma unroll
    for (int d0 = 0; d0 < 8; ++d0) qr[d0] = *(const bf16x8*)(Qp + (size_t)(wid * QBLK + r32) * PP + d0 * 16 + hi * 8);
    float qkb = 0.f;
    if (MODE == 0) { float sq = 0.f;
#pragma unroll
        for (int d0 = 0; d0 < 8; ++d0)
#pragma unroll
            for (int e = 0; e < 8; ++e) { const float v = bf2f((unsigned short)qr[d0][e]); sq = fmaf(v, v, sq); }
        { auto rr = __builtin_amdgcn_permlane32_swap(__float_as_uint(sq), __float_as_uint(sq), false, false); sq = __uint_as_float(rr[0]) + __uint_as_float(rr[1]); }
        qkb = sqrtf(sq) * sqrtf(T.KN[U.b * NH + U.h]) * C2 * 1.001f; }
    LAS unsigned* flags = (LAS unsigned*)(lds + LDS_FLAGS);
    if (MODE == 0) {
        const float* dl = T.DL + (size_t)(U.b * NH + U.h) * DL_PITCH;
        for (int i = tid; i < (jhi + 1) * 16; i += 512) *(LAS f32x4*)(aux + 4 * i) = *(const f32x4*)(dl + 4 * i);
    } else {
        int tt = tid; asm volatile("" : "+v"(tt));
        if (tt < 256) aux[tt] = T.relb[t5_bucket(tt - 192) * NH + U.h] * LOG2E;
    }
    VM_WAIT();
    __syncthreads();
    float cfar = 0.f; if (MODE == 1) cfar = aux[0];
    float m_reg = -1e30f, l_reg = 0; f32x16 o[4] = {};
    const unsigned moff = (unsigned)(U.b * LSEQ + qi) * (MASK_PITCH * 8u);
    const float NEG = -__builtin_inff();
#define ACT(t) (KVBLK * (t) <= qlo + QBLK - 1)
#define RESC(a) do { if (__any((a) < 1.f)) { if (hi == 0) al_l[r32] = (a); asm volatile("s_waitcnt lgkmcnt(0)" ::: "memory");              \
                     for (int d_ = 0; d_ < 4; ++d_) for (int r = 0; r < 16; ++r) o[d_][r] *= al_l[crow(r, hi)]; } } while (0)
#define BIASMASK(p0, p1, t_, mw) do {                                                                                                       \
        if (MODE == 0) {                                                                                                                    \
            const LAS float* dlt = aux + ((t_) + 1) * 64 + 4 * hi;                                                                          \
            _Pragma("unroll") for (int g = 0; g < 4; ++g) { const f32x4 d0_ = *(const LAS f32x4*)(dlt + 8 * g), d1_ = *(const LAS f32x4*)(dlt + 32 + 8 * g);   \
                _Pragma("unroll") for (int j = 0; j < 4; ++j) { p0[4 * g + j] = fmaf(p0[4 * g + j], C2, d0_[j]); p1[4 * g + j] = fmaf(p1[4 * g + j], C2, d1_[j]); } }   \
            if ((t_) < 0) {                                                                                  \
                _Pragma("unroll") for (int r = 0; r < 16; ++r) { p0[r] = NEG; if (r < 8) p1[r] = NEG; }                                     \
            } else if (KVBLK * (t_) + KVBLK - 1 > qlo) {                                         \
                const int dq = qi - KVBLK * (t_) - 4 * hi;                                                                                  \
                _Pragma("unroll") for (int r = 0; r < 16; ++r) { const int c = (r & 3) + 8 * (r >> 2); if (c > dq) p0[r] = NEG; if (c + 32 > dq) p1[r] = NEG; }   \
            }                                                                                                                               \
        } else {                                                                                                                            \
            if (KVBLK * (t_) + KVBLK - 1 - qlo >= -90) {                           \
                const LAS float* tb = aux + (KVBLK * (t_) - qi + 4 * hi + 192);                                                             \
                _Pragma("unroll") for (int r = 0; r < 16; ++r) { const int c = (r & 3) + 8 * (r >> 2); p0[r] = fmaf(p0[r], C2, tb[c]); p1[r] = fmaf(p1[r], C2, tb[c + 32]); }   \
            } else {                                                                                                                        \
                _Pragma("unroll") for (int r = 0; r < 16; ++r) { p0[r] = fmaf(p0[r], C2, cfar); p1[r] = fmaf(p1[r], C2, cfar); }           \
            }                                                                                                                               \
            const unsigned mlo = (unsigned)(mw) >> (4 * hi), mhi = (unsigned)((mw) >> 32) >> (4 * hi);                                      \
            _Pragma("unroll") for (int r = 0; r < 16; ++r) { const int c = (r & 3) + 8 * (r >> 2);                                          \
                const unsigned s0_ = (unsigned)__builtin_amdgcn_sbfe((int)mlo, c, 1), s1_ = (unsigned)__builtin_amdgcn_sbfe((int)mhi, c, 1);       \
                p0[r] = __uint_as_float((__float_as_uint(p0[r]) & s0_) | (0xff800000u & ~s0_));                                             \
                p1[r] = __uint_as_float((__float_as_uint(p1[r]) & s1_) | (0xff800000u & ~s1_)); }                                           \
        } } while (0)
#define MASKWORD(t_) (MODE == 1 ? *(const u64*)((const char*)(T.MASK + ((t_) + 1)) + (size_t)moff) : (u64)0)
#define STOPFLAG(kk, t_) do { if (MODE == 0) { const float dln_ = aux[(t_) * 64 + 63];                                           \
            const bool neg_ = __all(qkb + dln_ <= m_reg - SKIP_MARGIN) != 0;                                                                \
            if (lane == 0) flags[((kk) & 1) * 8 + wid] = neg_ ? 1u : 0u; } } while (0)
#define STOPREAD(kk) do { if (MODE == 0) { const v4u f0_ = *(const LAS v4u*)(flags + ((kk) & 1) * 8), f1_ = *(const LAS v4u*)(flags + ((kk) & 1) * 8 + 4);   \
            stop = (f0_.x & f0_.y & f0_.z & f0_.w & f1_.x & f1_.y & f1_.z & f1_.w) != 0u; } } while (0)
#define FAKEPA(P0_, P1_) do { v4u w0_ = {__float_as_uint(P0_[0]), __float_as_uint(P0_[1]), __float_as_uint(P0_[2]), __float_as_uint(P0_[3])}, w1_ = {__float_as_uint(P0_[8]), __float_as_uint(P0_[9]), __float_as_uint(P0_[10]), __float_as_uint(P0_[11])}, \
        w2_ = {__float_as_uint(P1_[0]), __float_as_uint(P1_[1]), __float_as_uint(P1_[2]), __float_as_uint(P1_[3])}, w3_ = {__float_as_uint(P1_[8]), __float_as_uint(P1_[9]), __float_as_uint(P1_[10]), __float_as_uint(P1_[11])}; \
        pa0 = *reinterpret_cast<bf16x8*>(&w0_); pa1 = *reinterpret_cast<bf16x8*>(&w1_); pa2 = *reinterpret_cast<bf16x8*>(&w2_); pa3 = *reinterpret_cast<bf16x8*>(&w3_); } while (0)
#define HALF_STEP(PX0, PX1, alX, PY0, PY1, alY, kk, KB, VB) do { const int t_ = TILE(kk); const bool more_ = t_ >= 0;                          \
        if (more_) DMA_K(t_ - 1, (KB) ^ 1);                                                                                                 \
        u64 mw_ = 0; if (ACT(t_)) mw_ = MASKWORD(t_);             \
        bf16x8 pa0, pa1, pa2, pa3;                                                                                                          \
        SBAR();                                                                                                                             \
        qkt<KB>(PX0, PX1, K_lds, r32, hi, qr);                                                                                              \
        if (NOSM) { FAKEPA(PY0, PY1); } else finishSM(PY0, PY1, alY, l_reg, pa0, pa1, pa2, pa3);                                            \
        SBAR();                                                                                                                             \
        pv_tile<VB>(o, vb0, pa0, pa1, pa2, pa3);                                                                                            \
        if (NOSM) { alX = 1.f; l_reg = 1.f; } else { BIASMASK(PX0, PX1, t_, mw_); partialSM(PX0, PX1, m_reg, alX); }                        \
        SBAR();                                                                                                                             \
        if (more_) STOPFLAG(kk, t_);                                                                                                        \
        VM_WAIT(); __syncthreads();                                                                                                         \
        if (more_) STOPREAD(kk);                                                                                                            \
        if (more_) DMA_V(t_ - 1, VB);                             \
        RESC(alX); SBAR(); } while (0)
    f32x16 pA0, pA1, pB0, pB1; float alA = 1.f, alB = 1.f; bool stop = false;
    {
        DMA_K(TILE(1), 1);
        u64 mw_ = 0; if (ACT(TILE(0))) mw_ = MASKWORD(TILE(0));
        SBAR();
        qkt<0>(pA0, pA1, K_lds, r32, hi, qr); if (NOSM) { l_reg = 1.f; } else { BIASMASK(pA0, pA1, TILE(0), mw_); partialSM(pA0, pA1, m_reg, alA); }
        SBAR();
        STOPFLAG(0, TILE(0));
        VM_WAIT(); __syncthreads();
        STOPREAD(0);
        DMA_V(TILE(1), 1);
    }
    int k;
    for (k = 1; k + 1 <= jhi && !stop; k += 2) {
        HALF_STEP(pB0, pB1, alB, pA0, pA1, alA, k, 1, 0);
        HALF_STEP(pA0, pA1, alA, pB0, pB1, alB, k + 1, 0, 1);
    }
    {
        bf16x8 pa0, pa1, pa2, pa3;
        if (NOSM) { FAKEPA(pA0, pA1); } else finishSM(pA0, pA1, alA, l_reg, pa0, pa1, pa2, pa3);
        SBAR(); pv_tile<0>(o, vb0, pa0, pa1, pa2, pa3);
    }
    if (hi == 0) li_l[r32] = l_reg; asm volatile("s_waitcnt lgkmcnt(0)" ::: "memory");
    bf16* Ow = T.O + (size_t)(U.b * LSEQ + qlo) * DM + MODE * WBR + U.h * HD;
    int le = lane; asm volatile("" : "+v"(le));
    const int r32e = le & 31, hie = le >> 5; const bool odd = (r32e & 1) != 0;
    const unsigned obase = (unsigned)((4 * hie) * DM + (odd ? 32 : 0) + (r32e & ~1)) * 2u;
#pragma unroll
    for (int r = 0; r < 16; ++r) { const int orow = crow(r, hi); const float rl = __builtin_amdgcn_rcpf(li_l[orow]);
#pragma unroll
        for (int dp = 0; dp < 2; ++dp) { const float va = o[2 * dp][r] * rl, vb = o[2 * dp + 1][r] * rl;
            const float y = __shfl_xor(odd ? va : vb, 1);
            const unsigned w = odd ? cvtpk(y, vb) : cvtpk(va, y);
            *(unsigned*)((char*)Ow + (size_t)(((r & 3) + 8 * (r >> 2)) * DM + 2 * dp * 32) * 2 + (size_t)obase) = w; } }
    VM_WAIT();
    __syncthreads();
#undef RESC
#undef ACT
#undef BIASMASK
#undef MASKWORD
#undef STOPFLAG
#undef STOPREAD
#undef HALF_STEP
#undef FAKEPA
#undef TILE
#undef DMA_K
#undef DMA_V
#undef KTILE
#undef VTILE
}
}

#ifndef IDX_ASMFMA
#define IDX_ASMFMA 0
#endif
#ifndef IDX_SELBAND
#define IDX_SELBAND 0
#endif
#ifndef IDX_SELASM
#define IDX_SELASM 0
#endif
#ifndef IDX_SELDPP
#define IDX_SELDPP 0
#endif
#ifndef IDX_REP
#define IDX_REP 1
#endif
#ifndef IDX_UNROLL
#define IDX_UNROLL 2
#endif
namespace idx {
constexpr int LDS_QL = 131072, LDS_W = LDS_QL + 8192, IDX_LDS_BYTES = LDS_W + 4096;
__device__ __forceinline__ size_t sc_row(int b, int i) { const int c = i >> 6; return (size_t)b * SC_PER_BATCH + (size_t)2048 * c * (c + 3) + (size_t)(i & 63) * 64 * (c + 2); }
__device__ __forceinline__ void index_unit(char* lds, const bf16* PROJ, const bf16* KI, const float* WI, float* SC, int b, int g) {
    const int tid = threadIdx.x, wid = __builtin_amdgcn_readfirstlane(tid >> 6), lane = tid & 63, r32 = lane & 31, hi = lane >> 5;
    const int row0 = b * LSEQ + 32 * g;
#pragma unroll 4
    for (int it = 0; it < 16; ++it) { const int id = it * 512 + tid, q = id >> 8, c8 = id & 255;
        const bf16x8 v = *(const bf16x8*)(PROJ + (size_t)(row0 + q) * PP + C_QI + c8 * 8);
        *(bf16x8*)(lds + (c8 >> 1) * 1024 + q * 32 + (c8 & 1) * 16) = v; }
    float* wl = (float*)(lds + LDS_W);
    if (tid < 256) { const int q = tid >> 3, h4 = tid & 7; const f32x4 w = *(const f32x4*)(WI + (size_t)(row0 + q) * 32 + 4 * h4);
#pragma unroll
        for (int j = 0; j < 4; ++j) wl[(4 * h4 + j) * 32 + q] = 0.5f * w[j]; }
    __syncthreads();
    {
        const int q = tid >> 4, d0 = 4 * (tid & 15), off = (d0 >> 4) * 1024 + q * 32 + ((d0 >> 3) & 1) * 16 + (d0 & 7) * 2;
        float a0 = 0.f, a1 = 0.f, a2 = 0.f, a3 = 0.f;
#pragma unroll 8
        for (int h = 0; h < HIDX; ++h) { const unsigned long long v = *(const unsigned long long*)(lds + h * 4096 + off); const float w = wl[h * 32 + q];
            a0 = fmaf(w, __uint_as_float((unsigned)v << 16), a0); a1 = fmaf(w, __uint_as_float((unsigned)v & 0xffff0000u), a1);
            a2 = fmaf(w, __uint_as_float((unsigned)(v >> 32) << 16), a2); a3 = fmaf(w, __uint_as_float((unsigned)(v >> 32) & 0xffff0000u), a3); }
        const unsigned h01 = pk2(a0, a1), h23 = pk2(a2, a3);
        const float r0 = a0 - __uint_as_float(h01 << 16), r1 = a1 - __uint_as_float(h01 & 0xffff0000u), r2 = a2 - __uint_as_float(h23 << 16), r3 = a3 - __uint_as_float(h23 & 0xffff0000u);
        *(unsigned long long*)(lds + LDS_QL + off) = (unsigned long long)h01 | ((unsigned long long)h23 << 32);
        *(unsigned long long*)(lds + LDS_QL + 4096 + off) = (unsigned long long)pk2(r0, r1) | ((unsigned long long)pk2(r2, r3) << 32);
    }
    __syncthreads();
    const int c = (32 * g) >> 6, nt = c + 2;
    float* scq = SC + sc_row(b, 32 * g + r32);
#pragma unroll 1
    for (int rep_ = 0; rep_ < IDX_REP; ++rep_)
    for (int k = wid; k < nt; k += 8) {
        const int krow0 = (k == 0) ? MROWS : b * LSEQ + (k - 1) * 64;
        bf16x8 ka[2][4];
#pragma unroll
        for (int kh = 0; kh < 2; ++kh)
#pragma unroll
            for (int ks = 0; ks < 4; ++ks) ka[kh][ks] = *(const bf16x8*)(KI + (size_t)(krow0 + 32 * kh + r32) * 64 + 16 * ks + 8 * hi);
        f32x16 a0 = {}, a1 = {};
#pragma unroll
        for (int hl = 0; hl < 2; ++hl) { const char* qb = lds + LDS_QL + hl * 4096 + r32 * 32 + hi * 16;
#pragma unroll
            for (int ks = 0; ks < 4; ++ks) { const bf16x8 bq = *(const bf16x8*)(qb + ks * 1024);
                a0 = __builtin_amdgcn_mfma_f32_32x32x16_bf16(ka[0][ks], bq, a0, 0, 0, 0);
                a1 = __builtin_amdgcn_mfma_f32_32x32x16_bf16(ka[1][ks], bq, a1, 0, 0, 0); } }
#pragma unroll IDX_UNROLL
        for (int h = 0; h < HIDX; ++h) {
            const char* qb = lds + h * 4096 + r32 * 32 + hi * 16;
            f32x16 d0 = {}, d1 = {};
#pragma unroll
            for (int ks = 0; ks < 4; ++ks) { const bf16x8 bq = *(const bf16x8*)(qb + ks * 1024);
                d0 = __builtin_amdgcn_mfma_f32_32x32x16_bf16(ka[0][ks], bq, d0, 0, 0, 0);
                d1 = __builtin_amdgcn_mfma_f32_32x32x16_bf16(ka[1][ks], bq, d1, 0, 0, 0); }
            const float w = wl[h * 32 + r32];
#if IDX_ASMFMA
            asm volatile("s_nop 13" : "+v"(d0), "+v"(d1));
#pragma unroll
            for (int r = 0; r < 16; ++r) { asm volatile("v_fma_f32 %0, %1, |%2|, %0" : "+v"(a0[r]) : "v"(w), "v"(d0[r])); asm volatile("v_fma_f32 %0, %1, |%2|, %0" : "+v"(a1[r]) : "v"(w), "v"(d1[r])); }
#else
#pragma unroll
            for (int r = 0; r < 16; ++r) { a0[r] = fmaf(w, fabsf(d0[r]), a0[r]); a1[r] = fmaf(w, fabsf(d1[r]), a1[r]); }
#endif
        }
        float* dst = scq + k * 64 + 4 * hi;
#pragma unroll
        for (int g4 = 0; g4 < 4; ++g4) { *(f32x4*)(dst + 8 * g4) = (f32x4){a0[4 * g4], a0[4 * g4 + 1], a0[4 * g4 + 2], a0[4 * g4 + 3]};
                                         *(f32x4*)(dst + 32 + 8 * g4) = (f32x4){a1[4 * g4], a1[4 * g4 + 1], a1[4 * g4 + 2], a1[4 * g4 + 3]}; }
    }
    asm volatile("s_waitcnt vmcnt(0)" ::: "memory");
    __syncthreads();
}
__device__ __forceinline__ int wave_sum_dpp(int v) {
    v += __builtin_amdgcn_update_dpp(0, v, 0x111, 0xf, 0xf, false);
    v += __builtin_amdgcn_update_dpp(0, v, 0x112, 0xf, 0xf, false);
    v += __builtin_amdgcn_update_dpp(0, v, 0x114, 0xf, 0xf, false);
    v += __builtin_amdgcn_update_dpp(0, v, 0x118, 0xf, 0xf, false);
    v += __builtin_amdgcn_update_dpp(0, v, 0x142, 0xa, 0xf, false);
    v += __builtin_amdgcn_update_dpp(0, v, 0x143, 0xc, 0xf, false);
    return __builtin_amdgcn_readlane(v, 63);
}
template <int NK>
__device__ __forceinline__ void select_query(const float* row, int nt, int nvalid, u64* mout, int lane, LAS unsigned* wscr) {
    unsigned key[NK];
#pragma unroll
    for (int k = 0; k < NK; ++k) { unsigned u = 0u;
        if (k < nt) { u = __float_as_uint(row[k * 64 + lane]); u = (u & 0x80000000u) ? ~u : (u | 0x80000000u); if (k == 0 && lane < 48) u = 0u; }
        key[k] = u; }
    unsigned thr = 1u;
    if (nvalid > KTOP) { thr = 0u; int lo = 64 * NK, hi = 0; (void)lo; (void)hi;
        for (int bit = 31; bit >= 0; --bit) { const unsigned cand = thr | (1u << bit);
#if IDX_SELDPP
            int c0 = 0, c1 = 0;
#pragma unroll
            for (int k = 0; k < NK; ++k) { if (k & 1) c1 += (key[k] >= cand) ? 1 : 0; else c0 += (key[k] >= cand) ? 1 : 0; }
            const int cnt = wave_sum_dpp(c0 + c1);
#elif IDX_SELASM
            int cnt = 0;
#pragma unroll
            for (int k0 = 0; k0 + 8 <= NK; k0 += 8) { u64 m0, m1, m2, m3, m4, m5, m6, m7;
                asm("v_cmp_ge_u32_e64 %0, %8, %16\n\tv_cmp_ge_u32_e64 %1, %9, %16\n\tv_cmp_ge_u32_e64 %2, %10, %16\n\tv_cmp_ge_u32_e64 %3, %11, %16\n\t"
                    "v_cmp_ge_u32_e64 %4, %12, %16\n\tv_cmp_ge_u32_e64 %5, %13, %16\n\tv_cmp_ge_u32_e64 %6, %14, %16\n\tv_cmp_ge_u32_e64 %7, %15, %16"
                    : "=&s"(m0), "=&s"(m1), "=&s"(m2), "=&s"(m3), "=&s"(m4), "=&s"(m5), "=&s"(m6), "=&s"(m7)
                    : "v"(key[k0]), "v"(key[k0 + 1]), "v"(key[k0 + 2]), "v"(key[k0 + 3]), "v"(key[k0 + 4]), "v"(key[k0 + 5]), "v"(key[k0 + 6]), "v"(key[k0 + 7]), "v"(cand));
                cnt += (__builtin_popcountll(m0) + __builtin_popcountll(m1)) + (__builtin_popcountll(m2) + __builtin_popcountll(m3)) + (__builtin_popcountll(m4) + __builtin_popcountll(m5)) + (__builtin_popcountll(m6) + __builtin_popcountll(m7)); }
#pragma unroll
            for (int k = NK & ~7; k < NK; ++k) cnt += __builtin_popcountll(__ballot(key[k] >= cand));
#else
            int cnt = 0;
#pragma unroll
            for (int k = 0; k < NK; ++k) cnt += __builtin_popcountll(__ballot(key[k] >= cand));
#endif
#if IDX_SELBAND
            if (cnt >= KTOP) { thr = cand; lo = cnt; } else hi = cnt;
            if (cnt == KTOP) break;
            if (thr != 0u && lo - hi <= 64 && bit > 0) {
                const unsigned span = 1u << bit; int base = 0;
#pragma unroll
                for (int k = 0; k < NK; ++k) { const bool inb = (key[k] - thr) < span; const u64 m = __ballot(inb);
                    const int pos = base + (int)__builtin_amdgcn_mbcnt_hi((unsigned)(m >> 32), __builtin_amdgcn_mbcnt_lo((unsigned)m, 0u));
                    if (inb) wscr[pos] = key[k];
                    base += __builtin_popcountll(m); }
                asm volatile("s_waitcnt lgkmcnt(0)" ::: "memory");
                const unsigned bk = lane < base ? wscr[lane] : 0u;
                for (int b2 = bit - 1; b2 >= 0; --b2) { const unsigned c2 = thr | (1u << b2); const int n2 = hi + __builtin_popcountll(__ballot(bk >= c2));
                    if (n2 >= KTOP) thr = c2;
                    if (n2 == KTOP) break; }
                break; } } }
#else
            if (cnt >= KTOP) thr = cand;
            if (cnt == KTOP) break; } }
#endif
    u64 mine = 0, w64 = 0, w65 = 0;
#pragma unroll
    for (int k = 0; k < NK; ++k) { const u64 bm = __ballot(key[k] >= thr); if (k < 64) { if (lane == k) mine = bm; } else if (k == 64) w64 = bm; else w65 = bm; }
    if (lane < nt) mout[lane] = mine;
    if (NK > 64 && nt > 64 && lane == 0) mout[64] = w64;
    (void)w65;
}
__device__ __forceinline__ void select_dispatch(const float* SC, u64* MASK, int b, int i, int lane, LAS unsigned* wscr) {
    const int c = i >> 6, nt = c + 2, nvalid = NMETA + 64 * (c + 1);
    const float* row = SC + sc_row(b, i); u64* mout = MASK + (size_t)(b * LSEQ + i) * MASK_PITCH;
    if (nt <= 17) select_query<17>(row, nt, nvalid, mout, lane, wscr);
    else if (nt <= 33) select_query<33>(row, nt, nvalid, mout, lane, wscr);
    else if (nt <= 49) select_query<49>(row, nt, nvalid, mout, lane, wscr);
    else select_query<65>(row, nt, nvalid, mout, lane, wscr);
}
__device__ __forceinline__ void knorm_unit(const bf16* PROJ, unsigned* KN2, int b, int h, int part) {
    const int tid = threadIdx.x, lane = tid & 63, wid = tid >> 6;
    constexpr int NKEY = LSEQ + NMETA, PER = NKEY / 4;
    float kmax = 0.f;
    constexpr int NIT = (PER + 31) / 32;
#pragma unroll 11
    for (int i = 0; i < NIT; ++i) { const int kq = i * 32 + wid * 4 + (lane >> 4); const bool ok = kq < PER; const int key = part * PER + (ok ? kq : 0);
        const int row = key < LSEQ ? b * LSEQ + key : METAROW + (key - LSEQ);
        const bf16x8 v = *(const bf16x8*)(PROJ + (size_t)row * PP + C_KA + h * HD + (lane & 15) * 8);
        float sq = 0.f;
#pragma unroll
        for (int e = 0; e < 8; ++e) { const float f = bf2f((unsigned short)v[e]); sq = fmaf(f, f, sq); }
        sq += __shfl_xor(sq, 1); sq += __shfl_xor(sq, 2); sq += __shfl_xor(sq, 4); sq += __shfl_xor(sq, 8);
        kmax = fmaxf(kmax, ok ? sq : 0.f); }
    kmax = fmaxf(kmax, __shfl_xor(kmax, 16)); kmax = fmaxf(kmax, __shfl_xor(kmax, 32));
    if (lane == 0) __hip_atomic_fetch_max(KN2 + b * NH + h, __float_as_uint(kmax), __ATOMIC_RELAXED, __HIP_MEMORY_SCOPE_AGENT);
}
__device__ __forceinline__ void scan_unit(char* lds, const float* LF, float* DL, int b, int h) {
    const int tid = threadIdx.x, lane = tid & 63, wid = tid >> 6;
    float* red = (float*)lds;
    float v[8], s = 0.f;
#pragma unroll
    for (int k = 0; k < 8; ++k) { v[k] = LF[(size_t)(b * LSEQ + 8 * tid + k) * 16 + h]; s += v[k]; v[k] = s; }
    float inc = s;
#pragma unroll
    for (int o = 1; o < 64; o <<= 1) { const float n = __shfl_up(inc, o); if (lane >= o) inc += n; }
    if (lane == 63) red[wid] = inc;
    float mt = 0.f, mcum = 0.f;
    for (int sidx = 0; sidx < NMETA; ++sidx) { const float x = LF[(size_t)(METAROW + sidx) * 16 + h]; mt += x; if (sidx <= tid) mcum = mt; }
    __syncthreads();
    float base = mt;
    for (int w = 0; w < wid; ++w) base += red[w];
    base += inc - s;
    float* dl = DL + (size_t)(b * NH + h) * DL_PITCH;
#pragma unroll
    for (int k = 0; k < 8; ++k) dl[64 + 8 * tid + k] = -LOG2E * (base + v[k]);
    if (tid < 48) dl[tid] = 0.f; else if (tid < 64) { }
    if (tid < NMETA) dl[48 + tid] = -LOG2E * mcum;
    __syncthreads();
}
}

constexpr int NWAVES = 8;
#define MK_N_LAUNCHES 1
constexpr int N_PHASES = 12;
constexpr int N_LAUNCHES = MK_N_LAUNCHES;
static_assert(N_LAUNCHES == 1 || N_LAUNCHES == N_PHASES, "MK_N_LAUNCHES is 1 or N_PHASES");

constexpr size_t MiB = 1u << 20;
constexpr size_t WS_CTL = 0, CTL_ZERO_BYTES = 1 * MiB;
constexpr size_t WS_WIN = 1 * MiB;
constexpr size_t WS_WBF = 179 * MiB;
constexpr size_t WS_WBD = 195 * MiB;
constexpr size_t WS_WO  = 211 * MiB;
constexpr size_t WS_U   = 244 * MiB;
constexpr size_t WS_SC  = WS_U;
constexpr size_t WS_LF  = 380 * MiB;
constexpr size_t WS_KI  = 382 * MiB;
constexpr size_t WS_WI  = 385 * MiB;
constexpr size_t WS_DL  = 388 * MiB;
constexpr size_t WS_MASK = 390 * MiB;
constexpr size_t WS_O   = 400 * MiB;
constexpr size_t WS_PROJ = 528 * MiB;
constexpr size_t WS_G   = 983 * MiB;
constexpr size_t WS_MIX = WS_PROJ;
constexpr size_t WS_ACT = WS_PROJ;
constexpr size_t WS_WUP = WS_WIN;
constexpr size_t WS_WDN = 1240 * MiB;
constexpr size_t WS_U8  = 1296 * MiB;
constexpr size_t WS_W8  = WS_O;
constexpr size_t WS_END = 1368 * MiB;
static_assert(WS_WIN + (size_t)NIN * DM * 2 <= WS_WBF && WS_U + (size_t)NB * SC_PER_BATCH * 4 <= WS_LF && WS_U + (size_t)MPAD * DM * 2 <= WS_LF, "ws map 1");
static_assert(WS_MASK + (size_t)MROWS * MASK_PITCH * 8 <= WS_O && WS_PROJ + (size_t)MPAD * PP * 2 <= WS_G && WS_ACT + (size_t)MROWS * DFF * 2 <= WS_WDN && WS_WUP + (size_t)DFF * DM * 2 <= WS_WBF && WS_G + (size_t)MROWS * 8192 * 2 <= WS_WDN && WS_WDN + (size_t)DFF * DM * 2 <= WS_END, "ws map 2");
constexpr int CW_TMO = 0, CW_CODE = 1, CW_BAR = 4096;

#ifndef P9_ALIGN
#define P9_ALIGN true
#endif
#ifndef P9_SP2
#define P9_SP2 true
#endif
#ifndef P9_EPIREP
#define P9_EPIREP 1
#endif
#ifndef PROBE_GEMM_L2
#define PROBE_GEMM_L2 0
#endif
#ifndef PROBE_ATT
#define PROBE_ATT 0
#endif
#ifndef PROBE_GEMM_MODE
#define PROBE_GEMM_MODE 0
#endif
#ifndef P1F_ALIGN
#define P1F_ALIGN true
#endif
#ifndef IDX_SELREP
#define IDX_SELREP 1
#endif
#ifndef DSA_BR_FP8
#define DSA_BR_FP8 1
#endif
#ifndef H1_BF16
#define H1_BF16 1
#endif
#ifndef H2_BF16
#define H2_BF16 1
#endif
#ifndef P9_DELAY
#define P9_DELAY 0
#endif
#ifndef P10_PMR
#define P10_PMR 8
#endif
constexpr int RING_OFF = 0;
constexpr int LDSCTL_OFF = 147456, MISC_OFF = LDSCTL_OFF + 320;
constexpr int LDS_BYTES = 151552;
static_assert(idx::IDX_LDS_BYTES + NWAVES * 256 <= LDSCTL_OFF && att::ATT_LDS_BYTES <= LDSCTL_OFF && pg8::STAGE_BYTES <= LDSCTL_OFF && MISC_OFF + 128 <= LDS_BYTES, "LDS map");

#define XB_TMO      128
#define XB_XCNT(j)  (256  + 64 * (j))
#define XB_XSUB(j)  (1280 + 64 * (j))
#define XB_XGEN(j)  (2304 + 64 * (j))
#define XB_TOP      3328
#define XB_TOPGEN   3392
#define XCD_BAR_WORDS 3456
#define XB_SPIN_CAP (1u << 18)

__device__ __forceinline__ unsigned xb_ld(unsigned* p)              { return __hip_atomic_load(p, __ATOMIC_RELAXED, __HIP_MEMORY_SCOPE_AGENT); }
__device__ __forceinline__ unsigned xb_add(unsigned* p, unsigned v) { return __hip_atomic_fetch_add(p, v, __ATOMIC_RELAXED, __HIP_MEMORY_SCOPE_AGENT); }
__device__ __forceinline__ unsigned xb_xcc_id() { return (unsigned)__builtin_amdgcn_s_getreg((3 << 11) | 20) & 0xFu; }
#define XB_SPIN(cond, bar) do { unsigned _sp = 0; while (cond) { __builtin_amdgcn_s_sleep(1); \
    if ((++_sp & 255u) == 0u) { if (xb_ld(&(bar)[XB_TMO])) break; if (_sp > XB_SPIN_CAP) { atomicAdd(&(bar)[XB_TMO], 1u); break; } } } } while (0)

struct XcdBarrier {
    unsigned* bar; unsigned x;
    volatile LAS unsigned* st;
};

__device__ __forceinline__ XcdBarrier xcd_barrier_post(unsigned* bar, volatile LAS unsigned* st) {
    XcdBarrier b; b.bar = bar; b.x = xb_xcc_id(); b.st = st;
    if (threadIdx.x == 0) (void)xb_add(&bar[XB_XCNT(b.x)], 1u);
    return b;
}
__device__ __forceinline__ void xcd_barrier_complete(unsigned* bar, unsigned x, unsigned& nloc, unsigned& nx) {
    const unsigned G = gridDim.x * gridDim.y * gridDim.z;
    unsigned sum, cnt, mine, sp = 0u;
    for (;;) {
        sum = 0u; cnt = 0u; mine = 0u;
#pragma unroll
        for (unsigned j = 0; j < 16; ++j) { const unsigned c = xb_ld(&bar[XB_XCNT(j)]); sum += c; cnt += (c > 0u) ? 1u : 0u; mine = (j == x) ? c : mine; }
        if (sum == G) break;
        __builtin_amdgcn_s_sleep(1);
        if ((++sp & 255u) == 0u) { if (xb_ld(&bar[XB_TMO])) break; if (sp > XB_SPIN_CAP) { atomicAdd(&bar[XB_TMO], 1u); break; } }
    }
    nloc = mine > 0u ? mine : 1u; nx = cnt > 0u ? cnt : 1u;
}

__device__ __forceinline__ void xcd_barrier(const XcdBarrier& b) {
    asm volatile("s_waitcnt vmcnt(0)" ::: "memory");
    __syncthreads();
    if (threadIdx.x == 0) {
        unsigned* bar = b.bar;
        __builtin_amdgcn_s_waitcnt(0);
        unsigned nloc = b.st[0], nx = b.st[1];
        if (nloc == 0u) { xcd_barrier_complete(bar, b.x, nloc, nx); b.st[0] = nloc; b.st[1] = nx; }
        const unsigned old = xb_add(&bar[XB_XSUB(b.x)], 1u);
        const unsigned gen = old / nloc;
        if (old + 1u == (gen + 1u) * nloc) {
            __builtin_amdgcn_fence(__ATOMIC_RELEASE, "agent");
            asm volatile("s_waitcnt vmcnt(0)" ::: "memory");
            const unsigned og = xb_add(&bar[XB_TOP], 1u);
            const unsigned tg = og / nx;
            if (og + 1u == (tg + 1u) * nx) xb_add(&bar[XB_TOPGEN], 1u);
            else XB_SPIN(xb_ld(&bar[XB_TOPGEN]) == tg, bar);
            __builtin_amdgcn_fence(__ATOMIC_ACQUIRE, "agent");
            xb_add(&bar[XB_XGEN(b.x)], 1u);
            asm volatile("s_waitcnt vmcnt(0)" ::: "memory");
        } else {
            XB_SPIN(xb_ld(&bar[XB_XGEN(b.x)]) == gen, bar);
            __builtin_amdgcn_fence(__ATOMIC_ACQUIRE, "agent");
            asm volatile("s_waitcnt vmcnt(0)" ::: "memory");
        }
    }
    __syncthreads();
}


__device__ __forceinline__ float wave_sum(float v) {
#pragma unroll
    for (int o = 1; o < 64; o <<= 1) v += __shfl_xor(v, o);
    return v;
}
__device__ __forceinline__ int win_src_col(int n) {
    if (n < 6144) return n;
    if (n < 14336) return n + 16;
    if (n < 22528) return n + 112;
    if (n < 22544) return 6144 + (n - 22528);
    if (n < 22608) return 14352 + (n - 22544);
    if (n < 22640) return 14416 + (n - 22608);
    return -1;
}
template <int MAP>
__device__ __forceinline__ void transpose_item(const float* W, int K, int Nsrc, int N, bf16* WT, LAS float* scr, int item, int lane, unsigned char* W8 = nullptr, const float* ksc = nullptr) {
    const int nblk = N / 32, kb = item / nblk, nb = item % nblk, k0 = 64 * kb, n0 = 32 * nb;
    const int nd = n0 + (lane & 31), ns = MAP == 1 ? win_src_col(nd) : nd;
    float tv[32];
    const float* wp = W + (size_t)(k0 + (lane >> 5)) * Nsrc + (ns >= 0 ? ns : 0);
#pragma unroll
    for (int i = 0; i < 32; ++i) tv[i] = wp[(size_t)(2 * i) * Nsrc];
#pragma unroll
    for (int i = 0; i < 32; ++i) scr[(2 * i + (lane >> 5)) * 33 + (lane & 31)] = ns >= 0 ? (ksc ? tv[i] * ksc[k0 + 2 * i + (lane >> 5)] : tv[i]) : 0.f;
    LDS_WAIT(); asm volatile("" ::: "memory");
    const int c = lane & 7;
    const bool isq = n0 < 2048 || (n0 >= 6144 && n0 < 8192), isk = (n0 >= 2048 && n0 < 4096) || (n0 >= 8192 && n0 < 10240), isv = (n0 >= 4096 && n0 < 6144) || (n0 >= 10240 && n0 < 12288);
    const bool isg = n0 >= 14336 && n0 < 22528;
    const bool f8 = MAP == 2 || (MAP == 1 && (isg || isv || (FP8_QK && (isq || isk)))), b16 = MAP != 2 && (!f8 || isk || isv);
    if (f8) {
#pragma unroll
        for (int j = 0; j < 4; ++j) { const int n = (lane >> 3) + 8 * j; const LAS float* s = scr + (8 * c) * 33 + n;
            int lo = 0, hi = 0;
            lo = __builtin_amdgcn_cvt_pk_fp8_f32(64.f * s[0 * 33], 64.f * s[1 * 33], lo, false); lo = __builtin_amdgcn_cvt_pk_fp8_f32(64.f * s[2 * 33], 64.f * s[3 * 33], lo, true);
            hi = __builtin_amdgcn_cvt_pk_fp8_f32(64.f * s[4 * 33], 64.f * s[5 * 33], hi, false); hi = __builtin_amdgcn_cvt_pk_fp8_f32(64.f * s[6 * 33], 64.f * s[7 * 33], hi, true);
            *(GAS u64*)(W8 + (size_t)(n0 + n) * K + k0 + 8 * c) = (u64)(unsigned)lo | ((u64)(unsigned)hi << 32); }
    }
    if (b16) {
#pragma unroll
    for (int j = 0; j < 4; ++j) { const int n = (lane >> 3) + 8 * j; const LAS float* s = scr + (8 * c) * 33 + n;
        v4u o; o.x = pk2(s[0 * 33], s[1 * 33]); o.y = pk2(s[2 * 33], s[3 * 33]); o.z = pk2(s[4 * 33], s[5 * 33]); o.w = pk2(s[6 * 33], s[7 * 33]);
        *(GAS v4u*)(WT + (size_t)(n0 + n) * K + k0 + 8 * c) = o; }
    }
    LDS_WAIT(); asm volatile("" ::: "memory");
}
template <bool F8 = false>
__device__ __forceinline__ void rms_row_to_bf16(const float* xrow, const float* g, bf16* orow, int lane, unsigned char* o8row = nullptr) {
    const GAS f32x4* xr = (const GAS f32x4*)xrow + lane; const GAS f32x4* gr = (const GAS f32x4*)g + lane;
    f32x4 v[16]; float s = 0.f;
#pragma unroll
    for (int j = 0; j < 16; ++j) { v[j] = xr[64 * j]; s += (v[j].x * v[j].x + v[j].y * v[j].y) + (v[j].z * v[j].z + v[j].w * v[j].w); }
    const float r = 1.0f / sqrtf(wave_sum(s) * (1.f / DM) + RMS_EPS);
    GAS u64* o8 = (GAS u64*)orow + lane;
#pragma unroll
    for (int j = 0; j < 16; ++j) { const f32x4 gg = gr[64 * j]; const float y0 = v[j].x * r * gg.x, y1 = v[j].y * r * gg.y, y2 = v[j].z * r * gg.z, y3 = v[j].w * r * gg.w;
        o8[64 * j] = (u64)pk2(y0, y1) | ((u64)pk2(y2, y3) << 32);
        if (F8) { int w = 0; w = __builtin_amdgcn_cvt_pk_fp8_f32(y0, y1, w, false); w = __builtin_amdgcn_cvt_pk_fp8_f32(y2, y3, w, true); ((GAS int*)o8row)[64 * j + lane] = w; } }
}
__device__ __forceinline__ void rms_row_inplace(float* xrow, const float* g, int lane) {
    GAS f32x4* xr = (GAS f32x4*)xrow + lane; const GAS f32x4* gr = (const GAS f32x4*)g + lane;
    f32x4 v[16]; float s = 0.f;
#pragma unroll
    for (int j = 0; j < 16; ++j) { v[j] = xr[64 * j]; s += (v[j].x * v[j].x + v[j].y * v[j].y) + (v[j].z * v[j].z + v[j].w * v[j].w); }
    const float r = 1.0f / sqrtf(wave_sum(s) * (1.f / DM) + RMS_EPS);
#pragma unroll
    for (int j = 0; j < 16; ++j) { const f32x4 gg = gr[64 * j]; xr[64 * j] = (f32x4){v[j].x * r * gg.x, v[j].y * r * gg.y, v[j].z * r * gg.z, v[j].w * r * gg.w}; }
}
__device__ __forceinline__ void rms_row_from_bf16(const bf16* hrow, const float* g, float* orow, int lane) {
    const GAS v4u* hr = (const GAS v4u*)hrow + lane;
    f32x4 a[8], b[8]; float s = 0.f;
#pragma unroll
    for (int j = 0; j < 8; ++j) { const v4u w = hr[64 * j];
        a[j] = (f32x4){__builtin_bit_cast(float, w.x << 16), __builtin_bit_cast(float, w.x & 0xffff0000u), __builtin_bit_cast(float, w.y << 16), __builtin_bit_cast(float, w.y & 0xffff0000u)};
        b[j] = (f32x4){__builtin_bit_cast(float, w.z << 16), __builtin_bit_cast(float, w.z & 0xffff0000u), __builtin_bit_cast(float, w.w << 16), __builtin_bit_cast(float, w.w & 0xffff0000u)};
        s += ((a[j].x * a[j].x + a[j].y * a[j].y) + (a[j].z * a[j].z + a[j].w * a[j].w)) + ((b[j].x * b[j].x + b[j].y * b[j].y) + (b[j].z * b[j].z + b[j].w * b[j].w)); }
    const float r = 1.0f / sqrtf(wave_sum(s) * (1.f / DM) + RMS_EPS);
#pragma unroll
    for (int j = 0; j < 8; ++j) { const size_t c = (size_t)(64 * j + lane) * 8; const f32x4 g0 = *(const GAS f32x4*)(g + c), g1 = *(const GAS f32x4*)(g + c + 4);
        *(GAS f32x4*)(orow + c) = (f32x4){a[j].x * r * g0.x, a[j].y * r * g0.y, a[j].z * r * g0.z, a[j].w * r * g0.w};
        *(GAS f32x4*)(orow + c + 4) = (f32x4){b[j].x * r * g1.x, b[j].y * r * g1.y, b[j].z * r * g1.z, b[j].w * r * g1.w}; }
}

struct Args { const float* in[13]; float* out; unsigned char* ws; int ph_lo, ph_hi; };
static_assert(sizeof(Args) == 13 * 8 + 8 + 8 + 8, "Args has no padding");
__global__ void __launch_bounds__(NWAVES * 64, 2) fwd(Args args) {
    extern __shared__ __attribute__((aligned(16))) unsigned char lds[];
    LAS unsigned char* ldsl = (LAS unsigned char*)lds;
    volatile LAS unsigned* MISC = (volatile LAS unsigned*)(ldsl + MISC_OFF);
    const int tid = threadIdx.x, lane = tid & 63, wave = __builtin_amdgcn_readfirstlane(tid >> 6);
    const int G = gridDim.x, bx = blockIdx.x;
    const int gw = bx * NWAVES + wave, NGW = G * NWAVES;
    unsigned char* ws = args.ws;
    gu32* ctl = (gu32*)(ws + WS_CTL);
    const float* x = args.in[0]; const float* meta = args.in[1]; const float* g_attn = args.in[2]; const float* w_in = args.in[3]; const float* fbias = args.in[4];
    const float* relb = args.in[5]; const float* w_bf = args.in[6]; const float* w_bd = args.in[7]; const float* w_o = args.in[8]; const float* g_mlp = args.in[9];
    const float* w_up = args.in[10]; const float* w_dn = args.in[11]; const float* g_fin = args.in[12]; float* out = args.out;
    bf16* WIN = (bf16*)(ws + WS_WIN); bf16* WBF = (bf16*)(ws + WS_WBF); bf16* WBD = (bf16*)(ws + WS_WBD); bf16* WO = (bf16*)(ws + WS_WO);
    bf16* WUP = (bf16*)(ws + WS_WUP); bf16* WDN = (bf16*)(ws + WS_WDN);
    bf16* U = (bf16*)(ws + WS_U); float* SC = (float*)(ws + WS_SC); float* LF = (float*)(ws + WS_LF); bf16* KI = (bf16*)(ws + WS_KI); float* WI = (float*)(ws + WS_WI);
    float* PS = (float*)(ws + WS_LF); float* RS2 = (float*)(ws + WS_LF + 6 * MiB);     float* DL = (float*)(ws + WS_DL); float* KN = (float*)(ws + WS_DL + 3 * MiB / 2); u64* MASK = (u64*)(ws + WS_MASK); bf16* OB = (bf16*)(ws + WS_O); bf16* PROJ = (bf16*)(ws + WS_PROJ); bf16* GB = (bf16*)(ws + WS_G);
    bf16* MIX = (bf16*)(ws + WS_MIX); bf16* ACT = (bf16*)(ws + WS_ACT); unsigned char* U8 = ws + WS_U8; unsigned char* W8 = ws + WS_W8; unsigned char* O8D = ws + WS_WIN + 129 * MiB;     unsigned char* MIX8 = ws + WS_MIX + 128 * MiB;
    for (int u = tid; u < (LDS_BYTES - LDSCTL_OFF) / 4; u += NWAVES * 64) ((LAS unsigned*)(ldsl + LDSCTL_OFF))[u] = 0u;
    __syncthreads();
    XcdBarrier bar; bar.bar = (unsigned*)(ctl + CW_BAR); bar.x = 0; bar.st = nullptr;
    if (N_LAUNCHES == 1) bar = xcd_barrier_post((unsigned*)(ctl + CW_BAR), MISC + 8);
    const int lo = args.ph_lo, hi = args.ph_hi;
#ifndef PHASE_MASK
#define PHASE_MASK 0xfff
#endif
#define IN(k) (((PHASE_MASK >> (k)) & 1) && lo <= (k) && (k) < hi)
#define SEAM(k) do { if (IN(k) && IN((k) + 1)) xcd_barrier(bar); } while (0)

    if (IN(0)) {
        LAS float* scr = (LAS float*)(ldsl + RING_OFF + wave * 16384);
        constexpr int I_IN = (DM / 64) * (NIN / 32);
        for (int it = gw; it < I_IN; it += NGW) transpose_item<1>(w_in, DM, DIN, NIN, WIN, scr, it, lane, W8);
        if (bx == 0 && tid < NB * NH) KN[tid] = 0.f;
        for (int m = gw; m < MPAD; m += NGW) {
            if (m < MROWS) rms_row_to_bf16<true>(x + (size_t)m * DM, g_attn, U + (size_t)m * DM, lane, U8 + (size_t)m * DM);
            else if (m >= METAROW && m < METAROW + NMETA) rms_row_to_bf16(meta + (size_t)(m - METAROW) * DM, g_attn, U + (size_t)m * DM, lane);
            else { GAS v4u* o = (GAS v4u*)(U + (size_t)m * DM) + lane;
#pragma unroll
                for (int j = 0; j < 8; ++j) o[64 * j] = (v4u){0u, 0u, 0u, 0u}; }
        }
    }
    SEAM(0);
    if (IN(1)) {
        {
            constexpr int P1X = (pg8::proj_bf16_tiles() * 64 + 33) % 256;
            constexpr int I_BR = (WBR / 64) * (DM / 32), I_O = (DM / 64) * (DM / 32);
            const int x0 = G > P1X ? P1X : 0;
            if (bx >= x0) {
                LAS float* scr = (LAS float*)(ldsl + RING_OFF + wave * 16384);
                for (int it = (bx - x0) * NWAVES + wave; it < 2 * I_BR + I_O; it += (G - x0) * NWAVES) {
                    int r = it;
                    if (r < I_BR) { transpose_item<0>(w_bf, WBR, DM, DM, WBF, scr, r, lane); continue; } r -= I_BR;
                    if (r < I_BR) { transpose_item<DSA_BR_FP8 ? 2 : 0>(w_bd, WBR, DM, DM, WBD, scr, r, lane, (unsigned char*)WBD); continue; } r -= I_BR;
                    transpose_item<W_OUT_FP8 ? 2 : 0>(w_o, DM, DM, DM, WO, scr, r, lane, (unsigned char*)WO);
                }
                __syncthreads();
            }
        }
        { pg8::Gemm g{U, WIN, DM, DM, DM}; pg8::ProjOrder S; S.init(MROWS, pg8::proj_bf16_tiles() * 256, G, bx);
          pg8::EpiProj E{PROJ, LF, KI, WI, fbias};
          pg8::gemm_phase<pg8::EpiProj, pg8::ProjOrder, true, true>(ldsl + RING_OFF, g, S, E); }
        { pg8::Gemm g{(const bf16*)U8, (const bf16*)W8, DM / 2, DM / 2, DM / 2};
          pg8::Proj8Order S; S.init(MROWS, pg8::proj_fp8_tiles() * 256, G, bx);
          pg8::EpiProj8 E{PROJ, GB};
          pg8::gemm_phase<pg8::EpiProj8, pg8::Proj8Order, P1F_ALIGN, true, 1, 0, true>(ldsl + RING_OFF, g, S, E); }
    }
    SEAM(1);
    if (IN(2)) {
        for (int u = bx; u < 4 * NB * NH; u += G) idx::knorm_unit(PROJ, (unsigned*)KN, (u >> 2) / NH, (u >> 2) % NH, u & 3);
        for (int u = bx; u < NB * NH; u += G) idx::scan_unit((char*)lds, LF, DL, u / NH, u % NH);
        for (int u = bx; u < 256; u += G) { const int b = u >> 6, g0 = u & 63;
            for (int k = 0; k < 2; ++k) { const int g = k == 0 ? 127 - g0 : g0;
                idx::index_unit((char*)lds, PROJ, KI, WI, SC, b, g);
                for (int j = 0; j < 4 * IDX_SELREP; ++j) idx::select_dispatch(SC, MASK, b, 32 * g + 4 * wave + (j & 3), lane, (LAS unsigned*)(ldsl + idx::IDX_LDS_BYTES + wave * 256)); } }
    }
    SEAM(2);
    if (IN(3)) {
        const att::Tensors T{PROJ, OB, DL, relb, MASK, KN};
        const int vcu = (G % 8 == 0) ? (bx % 8) * (G / 8) + bx / 8 : bx;
        for (int u = vcu; u < 256; u += G) { const int bh = u >> 2, q = u & 3;
            for (int k = 0; k < 4; ++k) { const int qb = k == 0 ? 15 - q : (k == 1 ? 11 - q : (k == 2 ? 4 + q : q));
                att::attn_unit<0>((LAS char*)ldsl, T, att::Unit{bh >> 4, bh & 15, qb}); } }
        for (int u = vcu; u < 256; u += G) { const int bh = u >> 2, q = u & 3;
            for (int k = 0; k < 4; ++k) { const int qb = k == 0 ? 15 - q : (k == 1 ? 11 - q : (k == 2 ? 4 + q : q));
                att::attn_unit<1>((LAS char*)ldsl, T, att::Unit{bh >> 4, bh & 15, qb});
#if DSA_BR_FP8
                {
                    const int row = (bh >> 4) * LSEQ + 256 * qb + (tid >> 1), c0 = (bh & 15) * HD + (tid & 1) * 64;
                    const GAS v4u* src = (const GAS v4u*)(OB + (size_t)row * DM + WBR + c0); GAS v4u* dst = (GAS v4u*)(O8D + (size_t)row * WBR + c0);
                    v4u in[8];
#pragma unroll
                    for (int j = 0; j < 8; ++j) in[j] = src[j];
#pragma unroll
                    for (int j = 0; j < 4; ++j) { v4u o;
#pragma unroll
                        for (int e = 0; e < 4; ++e) { const unsigned w0 = in[2 * j + (e >> 1)][2 * (e & 1)], w1 = in[2 * j + (e >> 1)][2 * (e & 1) + 1]; int pk = 0;
                            pk = __builtin_amdgcn_cvt_pk_fp8_f32(16.f * __uint_as_float(w0 << 16), 16.f * __uint_as_float(w0 & 0xffff0000u), pk, false);
                            pk = __builtin_amdgcn_cvt_pk_fp8_f32(16.f * __uint_as_float(w1 << 16), 16.f * __uint_as_float(w1 & 0xffff0000u), pk, true);
                            o[e] = (unsigned)pk; }
                        dst[j] = o; } }
#endif
            } }
    }
    SEAM(3);
    constexpr int I_UP = (DM / 64) * (DFF / 32), I_DN = (DFF / 64) * (DM / 32);
    const int cgrp = (bx >> 3) % 3, cgn = (((G >> 3) - cgrp + 2) / 3) * 8;
    const bool cstag = (G & 7) == 0 && (G >> 3) >= 3;
#define COPY_ITEMS(first, step, lo_, hi_) do { LAS float* scr = (LAS float*)(ldsl + RING_OFF + wave * 16384);                               \
        for (int it = (lo_) + (first); it < (hi_); it += (step)) { if (it < I_UP) transpose_item<0>(w_up, DM, DFF, DFF, WUP, scr, it, lane, nullptr, H1_BF16 ? g_mlp : nullptr); else transpose_item<0>(w_dn, DFF, DM, DM, WDN, scr, it - I_UP, lane); } \
        __syncthreads(); } while (0)
#define COPY_GROUP(k) do { if (cstag && cgrp == (k)) { const int lo_ = (int)(((long)(I_UP + I_DN) * (k)) / 3), hi_ = (int)(((long)(I_UP + I_DN) * ((k) + 1)) / 3);            \
        COPY_ITEMS((((bx >> 3) / 3) * 8 + (bx & 7)) * NWAVES + wave, cgn * NWAVES, lo_, hi_); } } while (0)
    if (IN(5)) {
        if (!cstag) COPY_ITEMS(gw, NGW, 0, I_UP + I_DN);
        COPY_GROUP(0);
        pg8::Gemm g{OB, WBF, DM, WBR, WBR}; pg8::StaticOrder S; S.init(MROWS, DM, G, bx);
        pg8::EpiGate<true> E{MIX, GB, 0, nullptr, 1.f};
        pg8::gemm_phase<pg8::EpiGate<true>, pg8::StaticOrder, true, true>(ldsl + RING_OFF, g, S, E);
    }
    if (IN(5) && IN(6)) { VM_WAIT(); __syncthreads(); }
    if (IN(6)) {
        COPY_GROUP(1);
        pg8::StaticOrder S; S.init(MROWS, DM, G, bx);
#if DSA_BR_FP8
        { pg8::Gemm g{(const bf16*)O8D, (const bf16*)WBD, WBR / 2, WBR / 2, WBR / 2};
          pg8::EpiGate<false> E{MIX, GB, DM, MIX8, 1.f / 1024.f};
          pg8::gemm_phase<pg8::EpiGate<false>, pg8::StaticOrder, true, true, 1, 0, true>(ldsl + RING_OFF, g, S, E); }
#else
        { pg8::Gemm g{OB + WBR, WBD, DM, WBR, WBR};
          pg8::EpiGate<false> E{MIX, GB, DM, MIX8, 1.f};
          pg8::gemm_phase<pg8::EpiGate<false>, pg8::StaticOrder, true, true>(ldsl + RING_OFF, g, S, E); }
#endif
        COPY_GROUP(2);
    }
#undef COPY_GROUP
#undef COPY_ITEMS
    SEAM(6);
    if (IN(7)) {
        pg8::StaticOrder S; S.init(MROWS, DM, G, bx);
        if constexpr (W_OUT_FP8) { pg8::Gemm g{(const bf16*)MIX8, (const bf16*)WO, DM / 2, DM / 2, DM / 2};
            pg8::EpiResidNorm E{x, out, U, g_mlp, PS, DM, 1.f / 1024.f};
            pg8::gemm_phase<pg8::EpiResidNorm, pg8::StaticOrder, true, true, 1, 0, true>(ldsl + RING_OFF, g, S, E); }
        else { pg8::Gemm g{MIX, WO, DM, DM, DM};
            pg8::EpiResidNorm E{x, out, U, g_mlp, PS, DM, 1.f};
            pg8::gemm_phase<pg8::EpiResidNorm, pg8::StaticOrder, true, true>(ldsl + RING_OFF, g, S, E); }
    }
    do { if (IN(7) && IN(9)) xcd_barrier(bar); } while (0);
    if (IN(9)) {
        pg8::Gemm g{U, WUP, DM, DM, DM}; pg8::UpOrder S; S.init(MROWS, DFF, G, bx);
        {
            pg8::Unit uu; int lastpm = -1;
            for (int i = 0; S.next(i, uu); ++i) if (uu.pm != lastpm) { lastpm = uu.pm;
                if (tid < 256) { const int m = uu.pm * 256 + tid; const f32x4* ps = (const f32x4*)(PS + (size_t)m * 64); float ss = 0.f;
#pragma unroll
                    for (int j = 0; j < 16; ++j) { const f32x4 v = ps[j]; ss += (v[0] + v[1]) + (v[2] + v[3]); }
                    RS2[m] = 1.0f / (ss * (1.f / DM) + RMS_EPS); } }
            VM_WAIT(); __syncthreads(); }
#if P9_DELAY > 0
        if ((bx >> 3) & 1) { for (int i = 0; i < P9_DELAY; ++i) __builtin_amdgcn_s_sleep(127); }
#endif
        pg8::EpiRelu2Scaled E{ACT, DFF, RS2};
        pg8::gemm_phase<pg8::EpiRelu2Scaled, pg8::UpOrder, P9_ALIGN, P9_SP2, P9_EPIREP>(ldsl + RING_OFF, g, S, E);
    }
    SEAM(9);
    if (IN(10)) {
        pg8::Gemm g{ACT, WDN, DFF, DFF, DFF}; pg8::PanelOrder<P10_PMR> S; S.init(MROWS, DM, G, bx);
#if H1_BF16
#if H2_BF16
        pg8::EpiResidHB E{U, DM};
        pg8::gemm_phase<pg8::EpiResidHB, pg8::PanelOrder<P10_PMR>, true, true>(ldsl + RING_OFF, g, S, E);
#else
        pg8::EpiResidB E{U, out, DM};
        pg8::gemm_phase<pg8::EpiResidB, pg8::PanelOrder<P10_PMR>, true, true>(ldsl + RING_OFF, g, S, E);
#endif
#else
        pg8::EpiResid E{out, out, DM};
        pg8::gemm_phase<pg8::EpiResid, pg8::PanelOrder<P10_PMR>, true, true>(ldsl + RING_OFF, g, S, E);
#endif
    }
    SEAM(10);
    if (IN(11)) {
#if H1_BF16 && H2_BF16
        for (int m = gw; m < MROWS; m += NGW) rms_row_from_bf16(U + (size_t)m * DM, g_fin, out + (size_t)m * DM, lane);
#else
        for (int m = gw; m < MROWS; m += NGW) rms_row_inplace(out + (size_t)m * DM, g_fin, lane);
#endif
    }
#if defined(PROBE_ATT) && PROBE_ATT
    xcd_barrier(bar);
    { const att::Tensors T{PROJ, U, DL, relb, MASK, KN};
      const int vcu = (G % 8 == 0) ? (bx % 8) * (G / 8) + bx / 8 : bx;
      for (int u = vcu; u < 256; u += G) { const int bh = u >> 2, q = u & 3;
          for (int k = 0; k < 4; ++k) { const int qb = k == 0 ? 15 - q : (k == 1 ? 11 - q : (k == 2 ? 4 + q : q));
              att::attn_unit<1, PROBE_ATT - 1>((LAS char*)ldsl, T, att::Unit{bh >> 4, bh & 15, qb}); } } }
#endif
#if defined(PROBE_GEMM_L2) && PROBE_GEMM_L2
    xcd_barrier(bar);
#if PROBE_GEMM_L2 == 1
    { pg8::Gemm g{U, WUP, DM, DM, DM}; pg8::ProbeOrder S; S.init(MROWS, DFF, G, bx);
      pg8::EpiRelu2 E{ACT, DFF};
      pg8::gemm_phase<pg8::EpiRelu2, pg8::ProbeOrder, true, true, 1, PROBE_GEMM_MODE>(ldsl + RING_OFF, g, S, E); }
#else
    { pg8::Gemm g{ACT, WDN, DFF, DFF, DFF}; pg8::ProbeOrder S; S.init(MROWS, DM, G, bx);
      pg8::EpiRelu2 E{U, DM};
      pg8::gemm_phase<pg8::EpiRelu2, pg8::ProbeOrder, true, true, 1, PROBE_GEMM_MODE>(ldsl + RING_OFF, g, S, E); }
#endif
#endif
#undef IN
#undef SEAM
}

extern "C" void kernel_launch(void* const* d_in, const int* in_sizes, int n_in, void* d_out, int out_size, void* d_ws, size_t ws_size, hipStream_t stream) {
    static int grid = 0;
    if (grid == 0) {
        if (n_in != 13 || in_sizes[0] != MROWS * DM || out_size != MROWS * DM || ws_size < WS_END) { fprintf(stderr, "kernel_launch: unexpected shapes (n_in %d, in0 %d, out %d, ws %zu < %zu); nothing launched\n", n_in, n_in > 0 ? in_sizes[0] : -1, out_size, ws_size, (size_t)WS_END); grid = -1; return; }
        int dev = 0, cus = 0, per_cu = 0;
        if (hipGetDevice(&dev) != hipSuccess || hipDeviceGetAttribute(&cus, hipDeviceAttributeMultiprocessorCount, dev) != hipSuccess) { grid = -1; return; }
        if (hipFuncSetAttribute((const void*)fwd, hipFuncAttributeMaxDynamicSharedMemorySize, LDS_BYTES) != hipSuccess) { fprintf(stderr, "kernel_launch: hipFuncSetAttribute failed\n"); grid = -1; return; }
        if (hipOccupancyMaxActiveBlocksPerMultiprocessor(&per_cu, (const void*)fwd, NWAVES * 64, LDS_BYTES) != hipSuccess || per_cu < 1) { fprintf(stderr, "kernel_launch: occupancy query says %d blocks per CU\n", per_cu); }
        (void)hipGetLastError();
        grid = cus;
    }
    if (grid < 0) return;
    if (hipMemsetAsync((char*)d_ws + WS_CTL, 0, CTL_ZERO_BYTES, stream) != hipSuccess) return;
    Args a{};
    for (int i = 0; i < 13; ++i) a.in[i] = (const float*)d_in[i];
    a.out = (float*)d_out; a.ws = (unsigned char*)d_ws;
    for (int li = 0; li < N_LAUNCHES; ++li) {
        a.ph_lo = (N_LAUNCHES == 1) ? 0 : li; a.ph_hi = (N_LAUNCHES == 1) ? N_PHASES : li + 1;
        hipLaunchKernelGGL(fwd, dim3(grid), dim3(NWAVES * 64), LDS_BYTES, stream, a);
        const hipError_t le = hipPeekAtLastError();
        if (le != hipSuccess) { fprintf(stderr, "kernel_launch: launch %d failed: %s\n", li, hipGetErrorName(le)); break; }
    }
}
```
